# Optimizing an MI355X kernel written in HIP

```python
import jax, jax.numpy as jnp
from jax import lax
import numpy as np

D_MODEL = 1024
BATCH = 8
SEQ = 4096
DEPTH = 2

CTX_LEN = 256
GRID_W = 64
Q_BLOCK = 128
ROPE_THETA = 10000.0
EPS = 1e-6

MLA_HEADS = 6
MLA_Q_RANK = 256
MLA_KV_RANK = 128
MLA_NOPE = 64
MLA_ROPE = 32
MLA_V = 64
MLA_WIDTH = MLA_HEADS * MLA_V
GQA_HEADS = 6
GQA_KV_HEADS = 2
GQA_HEAD_DIM = 64
GQA_WIDTH = GQA_HEADS * GQA_HEAD_DIM
CONV_CH = 256
CONV_K = 31
MIX_WIDTH = MLA_WIDTH + GQA_WIDTH + CONV_CH

L_MLA_KV = 0
L_MLA_KR = L_MLA_KV + MLA_KV_RANK
L_GQA_K = L_MLA_KR + MLA_ROPE
L_GQA_V = L_GQA_K + GQA_KV_HEADS * GQA_HEAD_DIM
KV_COLS = L_GQA_V + GQA_KV_HEADS * GQA_HEAD_DIM
OFF_MLA_Q = 0
OFF_KV = OFF_MLA_Q + MLA_Q_RANK
OFF_GQA_Q = OFF_KV + KV_COLS
OFF_CONV = OFF_GQA_Q + GQA_WIDTH
OFF_GATE = OFF_CONV + 2 * CONV_CH
IN_COLS = OFF_GATE + MIX_WIDTH

kernel_name = "hybrid_mla_gqa_conformer_dit"


def rms_norm(x, g):
    xf = x.astype(jnp.float32)
    y = xf * lax.rsqrt(jnp.mean(xf * xf, axis=-1, keepdims=True) + EPS)
    return (y * g.astype(jnp.float32)).astype(x.dtype)


def layer_norm(x, g, b):
    xf = x.astype(jnp.float32)
    mu = jnp.mean(xf, axis=-1, keepdims=True)
    var = jnp.mean(jnp.square(xf - mu), axis=-1, keepdims=True)
    y = (xf - mu) * lax.rsqrt(var + EPS) * g.astype(jnp.float32) + b.astype(jnp.float32)
    return y.astype(x.dtype)


def rope_1d(x, pos):
    half = x.shape[-1] // 2
    freqs = ROPE_THETA ** (-jnp.arange(half, dtype=jnp.float32) / half)
    ang = pos.astype(jnp.float32)[:, None] * freqs[None, :]
    cos = jnp.cos(ang)[None, :, None, :]
    sin = jnp.sin(ang)[None, :, None, :]
    xf = x.astype(jnp.float32)
    x1, x2 = xf[..., :half], xf[..., half:]
    return jnp.concatenate([x1 * cos - x2 * sin, x1 * sin + x2 * cos], axis=-1).astype(x.dtype)


def axial_rope(x, row, col):
    r = x.shape[-1] // 2
    return jnp.concatenate([rope_1d(x[..., :r], row), rope_1d(x[..., r:], col)], axis=-1)


def block_attention(q, k, v):
    B, S, H, D = q.shape
    G = k.shape[2]
    R = H // G
    Dv = v.shape[-1]
    scale = D ** -0.5
    nblk = S // Q_BLOCK
    qb = q.reshape(B, nblk, Q_BLOCK, G, R, D).transpose(1, 0, 2, 3, 4, 5)

    def one_block(qi):
        s = jnp.einsum('bqgrd,bkgd->bgrqk', qi, k).astype(jnp.float32) * scale
        p = jax.nn.softmax(s, axis=-1).astype(v.dtype)
        return jnp.einsum('bgrqk,bkgv->bqgrv', p, v)

    o = lax.map(one_block, qb)
    return o.transpose(1, 0, 2, 3, 4, 5).reshape(B, S, H * Dv)


def mla_query(p, q_norm, w_uq, row, col):
    B, T = p.shape[:2]
    cq = rms_norm(p[..., OFF_MLA_Q:OFF_MLA_Q + MLA_Q_RANK], q_norm)
    q = (cq @ w_uq).reshape(B, T, MLA_HEADS, MLA_NOPE + MLA_ROPE)
    if row is not None:
        q = jnp.concatenate([q[..., :MLA_NOPE], axial_rope(q[..., MLA_NOPE:], row, col)], axis=-1)
    return q


def mla_keys_values(pkv, kv_norm, w_ukv, row, col):
    B, T = pkv.shape[:2]
    ckv = rms_norm(pkv[..., L_MLA_KV:L_MLA_KR], kv_norm)
    kv = (ckv @ w_ukv).reshape(B, T, MLA_HEADS, MLA_NOPE + MLA_V)
    k_nope, v = kv[..., :MLA_NOPE], kv[..., MLA_NOPE:]
    k_rope = pkv[..., L_MLA_KR:L_GQA_K][:, :, None, :]
    if row is not None:
        k_rope = axial_rope(k_rope, row, col)
    k_rope = jnp.broadcast_to(k_rope, (B, T, MLA_HEADS, MLA_ROPE))
    return jnp.concatenate([k_nope, k_rope], axis=-1), v


def gqa_query(p, q_norm, row, col):
    B, T = p.shape[:2]
    q = rms_norm(p[..., OFF_GQA_Q:OFF_CONV].reshape(B, T, GQA_HEADS, GQA_HEAD_DIM), q_norm)
    if row is not None:
        q = axial_rope(q, row, col)
    return q


def gqa_keys_values(pkv, k_norm, row, col):
    B, T = pkv.shape[:2]
    k = rms_norm(pkv[..., L_GQA_K:L_GQA_V].reshape(B, T, GQA_KV_HEADS, GQA_HEAD_DIM), k_norm)
    if row is not None:
        k = axial_rope(k, row, col)
    v = pkv[..., L_GQA_V:KV_COLS].reshape(B, T, GQA_KV_HEADS, GQA_HEAD_DIM)
    return k, v


def conformer_conv(u, dw_w, dw_b, ln_w, ln_b, pw_w, pw_b):
    a, g = jnp.split(u, 2, axis=-1)
    y = a * jax.nn.sigmoid(g)
    y = lax.conv_general_dilated(
        y, dw_w[:, None, :], window_strides=(1,),
        padding=((CONV_K // 2, CONV_K // 2),),
        dimension_numbers=('NWC', 'WIO', 'NWC'),
        feature_group_count=CONV_CH) + dw_b
    y = jax.nn.silu(layer_norm(y, ln_w, ln_b))
    return y @ pw_w + pw_b


def hybrid_layer(x, ctx, c, c_ctx, row, col, last,
                 norm_w, w_mod, b_mod, w_in, mla_q_norm, mla_w_uq, mla_kv_norm, mla_w_ukv,
                 gqa_q_norm, gqa_k_norm, conv_dw_w, conv_dw_b, conv_ln_w, conv_ln_b,
                 conv_pw_w, conv_pw_b, w_out):
    shift, scale, gate = jnp.split(jax.nn.silu(c) @ w_mod + b_mod, 3, axis=-1)
    shift_c, scale_c, gate_c = jnp.split(jax.nn.silu(c_ctx) @ w_mod + b_mod, 3, axis=-1)
    h = rms_norm(x, norm_w) * (1.0 + scale[:, None, :]) + shift[:, None, :]
    hc = rms_norm(ctx, norm_w) * (1.0 + scale_c) + shift_c

    p = h @ w_in
    if last:
        pc_kv = hc @ w_in[:, OFF_KV:OFF_GQA_Q]
    else:
        pc = hc @ w_in
        pc_kv = pc[..., OFF_KV:OFF_GQA_Q]
    p_kv = p[..., OFF_KV:OFF_GQA_Q]

    k_mla_c, v_mla_c = mla_keys_values(pc_kv, mla_kv_norm, mla_w_ukv, None, None)
    k_gqa_c, v_gqa_c = gqa_keys_values(pc_kv, gqa_k_norm, None, None)

    k_mla, v_mla = mla_keys_values(p_kv, mla_kv_norm, mla_w_ukv, row, col)
    q_mla = mla_query(p, mla_q_norm, mla_w_uq, row, col)
    o_mla = block_attention(q_mla, jnp.concatenate([k_mla, k_mla_c], axis=1),
                            jnp.concatenate([v_mla, v_mla_c], axis=1))
    k_gqa, v_gqa = gqa_keys_values(p_kv, gqa_k_norm, row, col)
    q_gqa = gqa_query(p, gqa_q_norm, row, col)
    o_gqa = block_attention(q_gqa, jnp.concatenate([k_gqa, k_gqa_c], axis=1),
                            jnp.concatenate([v_gqa, v_gqa_c], axis=1))
    o_conv = conformer_conv(p[..., OFF_CONV:OFF_GATE], conv_dw_w, conv_dw_b,
                            conv_ln_w, conv_ln_b, conv_pw_w, conv_pw_b)
    y = jnp.concatenate([o_mla, o_gqa, o_conv], axis=-1) * jax.nn.silu(p[..., OFF_GATE:])
    x_new = x + gate[:, None, :] * (y @ w_out)

    if last:
        return x_new, ctx

    oc_mla = block_attention(mla_query(pc, mla_q_norm, mla_w_uq, None, None), k_mla_c, v_mla_c)
    oc_gqa = block_attention(gqa_query(pc, gqa_q_norm, None, None), k_gqa_c, v_gqa_c)
    oc_conv = conformer_conv(pc[..., OFF_CONV:OFF_GATE], conv_dw_w, conv_dw_b,
                             conv_ln_w, conv_ln_b, conv_pw_w, conv_pw_b)
    yc = jnp.concatenate([oc_mla, oc_gqa, oc_conv], axis=-1) * jax.nn.silu(pc[..., OFF_GATE:])
    ctx_new = ctx + gate_c * (yc @ w_out)
    return x_new, ctx_new


def setup_inputs(seed: int = 0) -> dict:
    key = jax.random.key(seed)
    ks = jax.random.split(key, 24)
    f32 = jnp.float32
    nrm = lambda k, shape, s: jax.random.normal(k, shape, f32) * s
    L, D = DEPTH, D_MODEL
    return {
        'x': nrm(ks[0], (BATCH, SEQ, D), 1.0),
        'c': nrm(ks[1], (BATCH, D), 1.0),
        'ctx': nrm(ks[2], (BATCH, CTX_LEN, D), 1.0),
        'c_ctx': nrm(ks[3], (D,), 1.0),
        'norm_w': 1.0 + nrm(ks[4], (L, D), 0.05),
        'w_mod': nrm(ks[5], (L, D, 3 * D), 0.5 * D ** -0.5),
        'b_mod': nrm(ks[6], (L, 3 * D), 0.02),
        'w_in': nrm(ks[7], (L, D, IN_COLS), D ** -0.5),
        'mla_q_norm': 1.0 + nrm(ks[8], (L, MLA_Q_RANK), 0.05),
        'mla_w_uq': nrm(ks[9], (L, MLA_Q_RANK, MLA_HEADS * (MLA_NOPE + MLA_ROPE)), MLA_Q_RANK ** -0.5),
        'mla_kv_norm': 1.0 + nrm(ks[10], (L, MLA_KV_RANK), 0.05),
        'mla_w_ukv': nrm(ks[11], (L, MLA_KV_RANK, MLA_HEADS * (MLA_NOPE + MLA_V)), MLA_KV_RANK ** -0.5),
        'gqa_q_norm': 1.0 + nrm(ks[12], (L, GQA_HEAD_DIM), 0.05),
        'gqa_k_norm': 1.0 + nrm(ks[13], (L, GQA_HEAD_DIM), 0.05),
        'conv_dw_w': nrm(ks[14], (L, CONV_K, CONV_CH), CONV_K ** -0.5),
        'conv_dw_b': nrm(ks[15], (L, CONV_CH), 0.02),
        'conv_ln_w': 1.0 + nrm(ks[16], (L, CONV_CH), 0.05),
        'conv_ln_b': nrm(ks[17], (L, CONV_CH), 0.02),
        'conv_pw_w': nrm(ks[18], (L, CONV_CH, CONV_CH), CONV_CH ** -0.5),
        'conv_pw_b': nrm(ks[19], (L, CONV_CH), 0.02),
        'w_out': nrm(ks[20], (L, MIX_WIDTH, D), MIX_WIDTH ** -0.5),
        'final_norm_w': 1.0 + nrm(ks[21], (D,), 0.05),
    }


def reference(x, c, ctx, c_ctx, norm_w, w_mod, b_mod, w_in, mla_q_norm, mla_w_uq, mla_kv_norm,
              mla_w_ukv, gqa_q_norm, gqa_k_norm, conv_dw_w, conv_dw_b, conv_ln_w, conv_ln_b,
              conv_pw_w, conv_pw_b, w_out, final_norm_w):
    S = x.shape[1]
    rows = S // GRID_W
    row = jnp.repeat(jnp.arange(rows, dtype=jnp.int32), GRID_W)
    col = jnp.tile(jnp.arange(GRID_W, dtype=jnp.int32), rows)
    for l in range(DEPTH):
        x, ctx = hybrid_layer(
            x, ctx, c, c_ctx, row, col, l == DEPTH - 1,
            norm_w[l], w_mod[l], b_mod[l], w_in[l], mla_q_norm[l], mla_w_uq[l],
            mla_kv_norm[l], mla_w_ukv[l], gqa_q_norm[l], gqa_k_norm[l],
            conv_dw_w[l], conv_dw_b[l], conv_ln_w[l], conv_ln_b[l],
            conv_pw_w[l], conv_pw_b[l], w_out[l])
    return rms_norm(x, final_norm_w)
```

```cpp
#include <hip/hip_runtime.h>
#include <hip/hip_cooperative_groups.h>
#include <cstdio>
#include <cstdint>
namespace cg = cooperative_groups;

#define DEVI __device__ __forceinline__
typedef unsigned short bfu;
typedef __attribute__((ext_vector_type(8))) short bf16x8;
typedef __attribute__((ext_vector_type(4))) short s16x4;
typedef __attribute__((ext_vector_type(16))) float f32x16;
typedef __attribute__((ext_vector_type(4))) float f32x4;
typedef __attribute__((ext_vector_type(4))) unsigned u32x4;
typedef __attribute__((ext_vector_type(2))) unsigned u32x2;

constexpr int NB = 8, SEQ = 4096, DM = 1024, CTX = 256, TK = SEQ + CTX;
constexpr int ML = NB * SEQ, MC = NB * CTX, MT = ML + MC;
constexpr int INC = 2592, INP = 2816;
constexpr int NTHR = 512;
constexpr float EPS = 1e-6f;
constexpr float LOG2E = 1.4426950408889634f;
constexpr float QS_M = 0.10206207261596575f * LOG2E;
constexpr float QS_G = 0.125f * LOG2E;
constexpr int PC_MLAQ = 0, PC_KV = 256, PC_KR = 384, PC_GK = 416, PC_GV = 544, PC_GQ = 672, PC_CONV = 1056, PC_GATE = 1568;

constexpr size_t al256(size_t x) { return (x + 255) / 256 * 256; }
constexpr size_t SZ_WIN = (size_t)INP * 1024 * 2, SZ_WUQ = (size_t)640 * 256 * 2, SZ_WUKV = (size_t)768 * 128 * 2, SZ_WPW = (size_t)256 * 256 * 2,
                 SZ_WOUT = (size_t)1024 * 1024 * 2;
constexpr size_t O_WIN = 0;
constexpr size_t O_WUQ = O_WIN + 2 * SZ_WIN;
constexpr size_t O_WUKV = O_WUQ + 2 * SZ_WUQ;
constexpr size_t O_WPW = O_WUKV + 2 * SZ_WUKV;
constexpr size_t O_WOUT = O_WPW + 2 * SZ_WPW;
constexpr size_t O_MOD = O_WOUT + 2 * SZ_WOUT;
constexpr size_t O_ROPE = O_MOD + al256((size_t)2 * 9 * 3072 * 4);
constexpr size_t O_STATS = O_ROPE + al256((size_t)3072 * 4);
constexpr size_t O_CTX1 = O_STATS + al256((size_t)MT * 2 * 4);
constexpr size_t O_H = O_CTX1 + (size_t)MC * 1024 * 4;
constexpr size_t O_P = O_H + (size_t)MT * 1024 * 2;
constexpr size_t O_QM = O_P + (size_t)MT * INC * 2;
constexpr size_t O_KM = O_QM + (size_t)NB * 6 * TK * 96 * 2;
constexpr size_t O_VM = O_KM + (size_t)NB * 6 * TK * 96 * 2;
constexpr size_t O_QG = O_VM + (size_t)NB * 6 * TK * 64 * 2;
constexpr size_t O_KG = O_QG + (size_t)NB * 6 * TK * 64 * 2;
constexpr size_t O_VG = O_KG + (size_t)NB * 2 * TK * 64 * 2;
constexpr size_t O_Z = O_VG + (size_t)NB * 2 * TK * 64 * 2;
constexpr size_t O_BAR = O_Z + (size_t)MT * 256 * 2;
constexpr size_t O_D = O_QM;
static_assert((size_t)MT * 1024 * 2 <= O_VM - O_QM, "d does not fit");
constexpr size_t O_XBAR = O_BAR + 256;
constexpr size_t O_END = O_XBAR + 3456 * 4;

struct Params {
  const float *x, *c, *ctx, *c_ctx, *norm_w, *w_mod, *b_mod, *w_in, *mla_q_norm, *mla_w_uq, *mla_kv_norm, *mla_w_ukv, *gqa_q_norm, *gqa_k_norm,
      *conv_dw_w, *conv_dw_b, *conv_ln_w, *conv_ln_b, *conv_pw_w, *conv_pw_b, *w_out, *final_norm_w;
  float* out;
  char* ws;
};

DEVI unsigned short f2bf(float f) { unsigned u = __float_as_uint(f); u += 0x7fffu + ((u >> 16) & 1u); return (unsigned short)(u >> 16); }
DEVI float bf2f(unsigned short h) { return __uint_as_float(((unsigned)h) << 16); }
DEVI unsigned pk2(float lo, float hi) { return (unsigned)f2bf(lo) | ((unsigned)f2bf(hi) << 16); }
DEVI unsigned cvtpk(float lo, float hi) { unsigned r; asm volatile("v_cvt_pk_bf16_f32 %0, %1, %2" : "=v"(r) : "v"(lo), "v"(hi)); return r; }
DEVI float bflo(unsigned w) { return __uint_as_float(w << 16); }
DEVI float bfhi(unsigned w) { return __uint_as_float(w & 0xffff0000u); }
DEVI int otid(int wv) { int t = (wv << 6) | (int)__builtin_amdgcn_mbcnt_hi(~0u, __builtin_amdgcn_mbcnt_lo(~0u, 0u)); asm volatile("" : "+v"(t)); return t; }
DEVI int obid() { int t = blockIdx.x; asm volatile("" : "+s"(t)); return t; }
DEVI char* ows(const char* p) { char* q = const_cast<char*>(p); asm volatile("" : "+s"(q)); return q; }
template <int X> DEVI float swz_xor(float v) { return __int_as_float(__builtin_amdgcn_ds_swizzle(__float_as_int(v), (X << 10) | 0x1f)); }
DEVI float wsum(float v) {
  v += swz_xor<1>(v); v += swz_xor<2>(v); v += swz_xor<4>(v); v += swz_xor<8>(v); v += swz_xor<16>(v);
  auto rr = __builtin_amdgcn_permlane32_swap(__float_as_uint(v), __float_as_uint(v), false, false);
  return __uint_as_float(rr[0]) + __uint_as_float(rr[1]);
}
DEVI float siluf(float v) { return v / (1.f + __expf(-v)); }
DEVI int crow(int r, int hi) { return (r & 3) + 8 * (r >> 2) + 4 * hi; }
DEVI f32x16 mfma32(bf16x8 a, bf16x8 b, f32x16 c) { return __builtin_amdgcn_mfma_f32_32x32x16_bf16(a, b, c, 0, 0, 0); }

DEVI void rowinfo(int row, int& b, int& t, int& v) {
  if (row < ML) { b = row >> 12; t = row & 4095; v = b; }
  else { int rc = row - ML; b = rc >> 8; t = SEQ + (rc & 255); v = 8; }
}

DEVI void prep_transpose(const float* __restrict__ src, bfu* __restrict__ dst, int K, int N, int Npad, const float* __restrict__ gk, int gtid, int gthreads) {
  const int items = Npad * (K / 8);
  for (int i = gtid; i < items; i += gthreads) {
    const int n = i % Npad, k8 = i / Npad;
    u32x4 w = {0u, 0u, 0u, 0u};
    if (n < N) {
      float v[8];
#pragma unroll
      for (int j = 0; j < 8; ++j) { float s = src[(size_t)(k8 * 8 + j) * N + n]; if (gk) s *= gk[k8 * 8 + j]; v[j] = s; }
      w[0] = pk2(v[0], v[1]); w[1] = pk2(v[2], v[3]); w[2] = pk2(v[4], v[5]); w[3] = pk2(v[6], v[7]);
    }
    *reinterpret_cast<u32x4*>(dst + (size_t)n * K + k8 * 8) = w;
  }
}

DEVI void sincos_d(double a, float& c, float& s) {
  const double TWO_PI = 6.283185307179586476925286766559;
  double k = rint(a / TWO_PI);
  double r = a - k * TWO_PI;
  double r2 = r * r, ts = r, ss = r, tc = 1.0, cc = 1.0;
#pragma unroll
  for (int n = 1; n <= 14; ++n) {
    ts *= -r2 / (double)((2 * n) * (2 * n + 1)); ss += ts;
    tc *= -r2 / (double)((2 * n - 1) * (2 * n)); cc += tc;
  }
  c = (float)cc; s = (float)ss;
}

DEVI void phase_prep(int wv, const Params& P, char* lds) {
  const int tid = otid(wv), wid = tid >> 6, lane = tid & 63;
  const int gtid = blockIdx.x * NTHR + tid, gthreads = gridDim.x * NTHR;
  float* sc = reinterpret_cast<float*>(lds);
  float* part = sc + 9 * 1024;
  float* mod = reinterpret_cast<float*>(P.ws + O_MOD);
  bool staged = false;
  for (int it = blockIdx.x; it < 96; it += gridDim.x) {
    if (!staged) {
      for (int idx = tid; idx < 9 * 1024; idx += NTHR) {
        int v = idx >> 10, k = idx & 1023;
        float cv = (v < 8) ? P.c[v * 1024 + k] : P.c_ctx[k];
        sc[idx] = siluf(cv);
      }
      staged = true;
    }
    __syncthreads();
    const int l = it / 48, j0 = (it % 48) * 64;
    const float* wm = P.w_mod + (size_t)l * 1024 * 3072 + j0 + lane;
    float acc[9];
#pragma unroll
    for (int v = 0; v < 9; ++v) acc[v] = 0.f;
    for (int k = wid * 128; k < wid * 128 + 128; k += 16) {
      float wv[16];
#pragma unroll
      for (int u = 0; u < 16; ++u) wv[u] = wm[(size_t)(k + u) * 3072];
#pragma unroll
      for (int v = 0; v < 9; ++v) {
        const float* s_ = sc + v * 1024 + k;
        float a_ = 0.f;
#pragma unroll
        for (int u = 0; u < 16; ++u) a_ += s_[u] * wv[u];
        acc[v] += a_;
      }
    }
#pragma unroll
    for (int v = 0; v < 9; ++v) part[(wid * 9 + v) * 64 + lane] = acc[v];
    __syncthreads();
    for (int o = tid; o < 9 * 64; o += NTHR) {
      int v = o >> 6, jl = o & 63;
      float s = P.b_mod[l * 3072 + j0 + jl];
#pragma unroll
      for (int w = 0; w < 8; ++w) s += part[(w * 9 + v) * 64 + jl];
      mod[((size_t)l * 9 + v) * 3072 + j0 + jl] = s;
    }
    __syncthreads();
  }
  if (gtid < 1536) {
    float* rt = reinterpret_cast<float*>(P.ws + O_ROPE);
    int pos, i, half; float* cdst; float* sdst;
    if (gtid < 512) { pos = gtid >> 3; i = gtid & 7; half = 8; cdst = rt + gtid; sdst = rt + 512 + gtid; }
    else { int g = gtid - 512; pos = g >> 4; i = g & 15; half = 16; cdst = rt + 1024 + g; sdst = rt + 2048 + g; }
    float freq = exp2f(-(float)i / (float)half * 13.287712379549449f);
    float ang = (float)pos * freq;
    float c, s; sincos_d((double)ang, c, s);
    *cdst = c; *sdst = s;
  }
}

DEVI void phase_wprep(int wv, const Params& P) {
  const int tid = otid(wv);
  const int gtid = blockIdx.x * NTHR + tid, gthreads = gridDim.x * NTHR;
  for (int l = 0; l < 2; ++l) {
    prep_transpose(P.w_in + (size_t)l * 1024 * INC, reinterpret_cast<bfu*>(P.ws + O_WIN + l * SZ_WIN), 1024, INC, INP, nullptr, gtid, gthreads);
    prep_transpose(P.mla_w_uq + (size_t)l * 256 * 576, reinterpret_cast<bfu*>(P.ws + O_WUQ + l * SZ_WUQ), 256, 576, 640, P.mla_q_norm + l * 256, gtid, gthreads);
    prep_transpose(P.mla_w_ukv + (size_t)l * 128 * 768, reinterpret_cast<bfu*>(P.ws + O_WUKV + l * SZ_WUKV), 128, 768, 768, P.mla_kv_norm + l * 128, gtid, gthreads);
    prep_transpose(P.conv_pw_w + (size_t)l * 256 * 256, reinterpret_cast<bfu*>(P.ws + O_WPW + l * SZ_WPW), 256, 256, 256, nullptr, gtid, gthreads);
    prep_transpose(P.w_out + (size_t)l * 1024 * 1024, reinterpret_cast<bfu*>(P.ws + O_WOUT + l * SZ_WOUT), 1024, 1024, 1024, nullptr, gtid, gthreads);
  }
}

DEVI void phase_hnorm(int wv, const Params& P, int layer) {
  const int tid = otid(wv), wid = tid >> 6, lane = tid & 63;
  const int gw = blockIdx.x * (NTHR / 64) + wid, nw = gridDim.x * (NTHR / 64);
  const float* mod = reinterpret_cast<const float*>(P.ws + O_MOD) + (size_t)layer * 9 * 3072;
  const float* nwp = P.norm_w + layer * 1024;
  bfu* hb = reinterpret_cast<bfu*>(P.ws + O_H);
  const float* xl = P.x;
  const float* xc = P.ctx;
  const bfu* dbuf = reinterpret_cast<const bfu*>(P.ws + O_D);
  const float* mod0 = reinterpret_cast<const float*>(P.ws + O_MOD);
  for (int row0 = gw; row0 < MT; row0 += 4 * nw) {
    f32x4 xv[4][4]; u32x2 dv[4][4];
#pragma unroll
    for (int q = 0; q < 4; ++q) {
      const int row = row0 + q * nw;
      if (row < MT) {
        const float* src = row < ML ? xl + (size_t)row * 1024 : xc + (size_t)(row - ML) * 1024;
#pragma unroll
        for (int i = 0; i < 4; ++i) xv[q][i] = *reinterpret_cast<const f32x4*>(src + (i * 64 + lane) * 4);
        if (layer == 1) {
#pragma unroll
          for (int i = 0; i < 4; ++i) dv[q][i] = *reinterpret_cast<const u32x2*>(dbuf + (size_t)row * 1024 + (i * 64 + lane) * 4);
        }
      }
    }
#pragma unroll
    for (int q = 0; q < 4; ++q) {
      const int row = row0 + q * nw;
      if (row < MT) {
        int b, t, v; rowinfo(row, b, t, v);
        if (layer == 1) {
          float* xdst = row < ML ? P.out + (size_t)row * 1024 : reinterpret_cast<float*>(P.ws + O_CTX1) + (size_t)(row - ML) * 1024;
#pragma unroll
          for (int i = 0; i < 4; ++i) {
            const int col = (i * 64 + lane) * 4;
            const f32x4 g0 = *reinterpret_cast<const f32x4*>(mod0 + (size_t)v * 3072 + 2048 + col);
            xv[q][i][0] += g0[0] * bflo(dv[q][i][0]); xv[q][i][1] += g0[1] * bfhi(dv[q][i][0]);
            xv[q][i][2] += g0[2] * bflo(dv[q][i][1]); xv[q][i][3] += g0[3] * bfhi(dv[q][i][1]);
            *reinterpret_cast<f32x4*>(xdst + col) = xv[q][i];
          }
        }
        float ss = 0.f;
#pragma unroll
        for (int i = 0; i < 4; ++i) ss += xv[q][i][0] * xv[q][i][0] + xv[q][i][1] * xv[q][i][1] + xv[q][i][2] * xv[q][i][2] + xv[q][i][3] * xv[q][i][3];
        ss = wsum(ss);
        const float r = rsqrtf(ss * (1.f / 1024.f) + EPS);
        const float* shp = mod + (size_t)v * 3072; const float* scp = shp + 1024;
#pragma unroll
        for (int i = 0; i < 4; ++i) {
          const int col = (i * 64 + lane) * 4;
          f32x4 g = *reinterpret_cast<const f32x4*>(nwp + col), s1 = *reinterpret_cast<const f32x4*>(scp + col), s0 = *reinterpret_cast<const f32x4*>(shp + col);
          float o0 = xv[q][i][0] * r * g[0] * (1.f + s1[0]) + s0[0], o1 = xv[q][i][1] * r * g[1] * (1.f + s1[1]) + s0[1];
          float o2 = xv[q][i][2] * r * g[2] * (1.f + s1[2]) + s0[2], o3 = xv[q][i][3] * r * g[3] * (1.f + s1[3]) + s0[3];
          u32x2 w = {pk2(o0, o1), pk2(o2, o3)};
          *reinterpret_cast<u32x2*>(hb + (size_t)row * 1024 + col) = w;
        }
      }
    }
  }
}

constexpr int GROW = 144;
constexpr int G_A_BYTES = 256 * GROW;
constexpr int g_stage(int wn) { return G_A_BYTES + 64 * wn * GROW; }
constexpr int LDS_BYTES = 2 * g_stage(4);
enum { EPI_P = 0, EPI_Q = 1, EPI_KV = 2, EPI_CONV = 3, EPI_OUT = 4 };

struct NextTile { const bfu* A; const bfu* Bt; int lda, ldb, m0, n0; bool valid; };
template <int EPI, int WN>
DEVI void gemm_tile(const bfu* __restrict__ A, int lda, const bfu* __restrict__ Bt, int ldb, int K, int m0, int n0, char* lds, const Params& P, int layer, int tid,
                    u32x4 (&ra)[4], u32x4 (&rb)[WN], bool have_pref, const NextTile& nx) {
  const int wid = tid >> 6, lane = tid & 63, r32 = lane & 31, hi = lane >> 5;
  constexpr int MI = WN, G_STAGE = g_stage(WN);
  const int wm = wid / WN, wn = wid % WN;
  const int srow = tid >> 3, sch = tid & 7;
  const bfu* Ag = A + (size_t)(m0 + srow) * lda + sch * 8;
  const bfu* Bg = Bt + (size_t)(n0 + srow) * ldb + sch * 8;
  f32x16 acc[MI][2];
#pragma unroll
  for (int i = 0; i < MI; ++i)
#pragma unroll
    for (int j = 0; j < 2; ++j)
#pragma unroll
      for (int r = 0; r < 16; ++r) acc[i][j][r] = 0.f;
  const int nk = K / 64;
#define GLOAD(k0) do { _Pragma("unroll") for (int i = 0; i < 4; ++i) ra[i] = *reinterpret_cast<const u32x4*>(Ag + (size_t)(64 * i) * lda + (k0)); \
    _Pragma("unroll") for (int i = 0; i < WN; ++i) rb[i] = *reinterpret_cast<const u32x4*>(Bg + (size_t)(64 * i) * ldb + (k0)); } while (0)
#define LWRITE(buf) do { char* a_ = lds + (buf) * G_STAGE; _Pragma("unroll") for (int i = 0; i < 4; ++i) *reinterpret_cast<u32x4*>(a_ + (srow + 64 * i) * GROW + sch * 16) = ra[i]; \
    char* b_ = a_ + G_A_BYTES; _Pragma("unroll") for (int i = 0; i < WN; ++i) *reinterpret_cast<u32x4*>(b_ + (srow + 64 * i) * GROW + sch * 16) = rb[i]; } while (0)
#define LDFR(kk, B0, B1, AF) do { B0 = *reinterpret_cast<const bf16x8*>(fb + (kk) * 32); B1 = *reinterpret_cast<const bf16x8*>(fb + 32 * GROW + (kk) * 32); \
    _Pragma("unroll") for (int mi = 0; mi < MI; ++mi) AF[mi] = *reinterpret_cast<const bf16x8*>(fa + mi * 32 * GROW + (kk) * 32); } while (0)
#define MM(B0, B1, AF) do { _Pragma("unroll") for (int mi = 0; mi < MI; ++mi) { acc[mi][0] = mfma32(AF[mi], B0, acc[mi][0]); acc[mi][1] = mfma32(AF[mi], B1, acc[mi][1]); } } while (0)
  bf16x8 b0x, b1x, afx[MI], b0y, b1y, afy[MI];
#define PIECE_A(i) do { if (kt + 1 < nk) *reinterpret_cast<u32x4*>(wbase + (srow + 64 * (i)) * GROW + sch * 16) = ra[i]; \
    if (kt + 2 < nk) ra[i] = *reinterpret_cast<const u32x4*>(Ag + (size_t)(64 * (i)) * lda + (kt + 2) * 64); } while (0)
#define PIECE_B(i) do { if (kt + 1 < nk) *reinterpret_cast<u32x4*>(wbase + G_A_BYTES + (srow + 64 * (i)) * GROW + sch * 16) = rb[i]; \
    if (kt + 2 < nk) rb[i] = *reinterpret_cast<const u32x4*>(Bg + (size_t)(64 * (i)) * ldb + (kt + 2) * 64); } while (0)
#define SB_() __builtin_amdgcn_sched_barrier(0)
  if (have_pref) {
#pragma unroll
    for (int i = 0; i < WN; ++i) rb[i] = *reinterpret_cast<const u32x4*>(Bg + (size_t)(64 * i) * ldb);
  } else GLOAD(0);
  LWRITE(0);
  if (1 < nk) GLOAD(64);
  __syncthreads();
  for (int kt = 0; kt < nk; ++kt) {
    const char* fa = lds + (kt & 1) * G_STAGE + (wm * (MI * 32) + r32) * GROW + hi * 16;
    const char* fb = lds + (kt & 1) * G_STAGE + G_A_BYTES + (wn * 64 + r32) * GROW + hi * 16;
    char* wbase = lds + ((kt + 1) & 1) * G_STAGE;
    LDFR(0, b0x, b1x, afx);
    LDFR(1, b0y, b1y, afy);
    SB_(); MM(b0x, b1x, afx); SB_();
    PIECE_A(0); PIECE_A(1);
    LDFR(2, b0x, b1x, afx);
    SB_(); MM(b0y, b1y, afy); SB_();
    PIECE_A(2); PIECE_A(3);
    LDFR(3, b0y, b1y, afy);
    SB_(); MM(b0x, b1x, afx); SB_();
    PIECE_B(0); if constexpr (WN == 4) PIECE_B(1);
    SB_(); MM(b0y, b1y, afy); SB_();
    if constexpr (WN == 4) { PIECE_B(2); PIECE_B(3); } else { PIECE_B(1); }
    __syncthreads();
  }
  if (nx.valid) {
    const bfu* An_ = nx.A + (size_t)(nx.m0 + srow) * nx.lda + sch * 8;
#pragma unroll
    for (int i = 0; i < 4; ++i) ra[i] = *reinterpret_cast<const u32x4*>(An_ + (size_t)(64 * i) * nx.lda);
  }
#undef PIECE_A
#undef PIECE_B
#undef SB_
#undef GLOAD
#undef LWRITE
#undef LDFR
#undef MM
  const bool latent = m0 < ML;
  const int tb_b = latent ? (m0 >> 12) : ((m0 - ML) >> 8), tb_t = latent ? (m0 & 4095) : SEQ;
  bfu* pbuf = reinterpret_cast<bfu*>(P.ws + O_P);
  const float* stats = reinterpret_cast<const float*>(P.ws + O_STATS);
  {
    char* reg = lds + G_STAGE + wid * (32 * GROW);
    const float* rt = reinterpret_cast<const float*>(P.ws + O_ROPE);
    const int cw0 = n0 + wn * 64;
    float cbias[2] = {0.f, 0.f};
    if constexpr (EPI == EPI_CONV) { cbias[0] = P.conv_pw_b[layer * 256 + cw0 + r32]; cbias[1] = P.conv_pw_b[layer * 256 + cw0 + 32 + r32]; }
#pragma unroll
    for (int mi = 0; mi < MI; ++mi) {
      float st[16];
      if constexpr (EPI == EPI_Q || EPI == EPI_KV) {
#pragma unroll
        for (int r = 0; r < 16; ++r) st[r] = stats[(m0 + wm * (MI * 32) + mi * 32 + crow(r, hi)) * 2 + (EPI == EPI_KV ? 1 : 0)];
      }
#pragma unroll
      for (int ni = 0; ni < 2; ++ni) {
        const int nb = cw0 + ni * 32;
        bool rope = false;
        if constexpr (EPI == EPI_Q) rope = latent && ((nb % 96) / 32 == 2) && (nb < 576);
        float cs[16], sn[16];
        if constexpr (EPI == EPI_Q) {
          if (rope) {
            const int sec = r32 >> 4, fi = r32 & 7;
#pragma unroll
            for (int r = 0; r < 16; ++r) {
              const int t = tb_t + wm * (MI * 32) + mi * 32 + crow(r, hi); const int pos = sec ? (t & 63) : (t >> 6);
              cs[r] = rt[pos * 8 + fi]; sn[r] = rt[512 + pos * 8 + fi];
            }
          }
        }
#pragma unroll
        for (int r = 0; r < 16; ++r) {
          float v = acc[mi][ni][r];
          if constexpr (EPI == EPI_Q || EPI == EPI_KV) v *= st[r];
          if constexpr (EPI == EPI_CONV) v += cbias[ni];
          if constexpr (EPI == EPI_Q) {
            if (rope) { const float pn = swz_xor<8>(v); v = !(r32 & 8) ? (v * cs[r] - pn * sn[r]) : (pn * sn[r] + v * cs[r]); }
            v *= QS_M;
          }
          *reinterpret_cast<bfu*>(reg + crow(r, hi) * GROW + (ni * 32 + r32) * 2) = f2bf(v);
        }
      }
#pragma unroll
      for (int i = 0; i < 4; ++i) {
        const int q_ = lane + 64 * i, rr = q_ >> 3, ch = q_ & 7;
        const u32x4 w = *reinterpret_cast<const u32x4*>(reg + rr * GROW + ch * 16);
        const int lr = wm * (MI * 32) + mi * 32 + rr, colc = cw0 + ch * 8;
        if constexpr (EPI == EPI_P) {
          if (colc < INC) *reinterpret_cast<u32x4*>(pbuf + (size_t)(m0 + lr) * INC + colc) = w;
        } else if constexpr (EPI == EPI_Q) {
          if (colc < 576) { const int h = colc / 96, d = colc % 96;
            *reinterpret_cast<u32x4*>(reinterpret_cast<bfu*>(P.ws + O_QM) + ((size_t)(tb_b * 6 + h) * TK + tb_t + lr) * 96 + d) = w; }
        } else if constexpr (EPI == EPI_OUT) {
          *reinterpret_cast<u32x4*>(reinterpret_cast<bfu*>(P.ws + O_D) + (size_t)(m0 + lr) * 1024 + colc) = w;
        } else if constexpr (EPI == EPI_CONV) {
          const u32x4 gw = *reinterpret_cast<const u32x4*>(pbuf + (size_t)(m0 + lr) * INC + PC_GATE + 768 + colc);
          u32x4 o;
#pragma unroll
          for (int j = 0; j < 4; ++j) o[j] = pk2(bflo(w[j]) * siluf(bflo(gw[j])), bfhi(w[j]) * siluf(bfhi(gw[j])));
          *reinterpret_cast<u32x4*>(reinterpret_cast<bfu*>(P.ws + O_H) + (size_t)(m0 + lr) * 1024 + 768 + colc) = o;
        } else {
          const int h = colc >> 7, e = colc & 127;
          bfu* dst = (e < 64) ? reinterpret_cast<bfu*>(P.ws + O_KM) + ((size_t)(tb_b * 6 + h) * TK + tb_t + lr) * 96 + e
                              : reinterpret_cast<bfu*>(P.ws + O_VM) + ((size_t)(tb_b * 6 + h) * TK + tb_t + lr) * 64 + (e - 64);
          *reinterpret_cast<u32x4*>(dst) = w;
        }
      }
    }
  }
}

DEVI void blk_group(int& grp, int& loc, int& per, int& ngrp) {
  const int nb = gridDim.x;
  if ((nb & 7) == 0) { grp = blockIdx.x & 7; loc = blockIdx.x >> 3; per = nb >> 3; ngrp = 8; }
  else { grp = 0; loc = blockIdx.x; per = nb; ngrp = 1; }
}

DEVI void phase_gemm_in(int wv, const Params& P, int layer, bool last, char* lds) {
  const int tid = otid(wv);
  const bfu* A = reinterpret_cast<const bfu*>(P.ws + O_H);
  const bfu* Bt = reinterpret_cast<const bfu*>(P.ws + O_WIN + layer * SZ_WIN);
  constexpr int PANELS = MT / 256, NT = INP / 256;
  int grp, loc, per, ngrp; blk_group(grp, loc, per, ngrp);
  const int PG = PANELS / ngrp, g0 = grp * PG;
  const NextTile none{nullptr, nullptr, 0, 0, 0, 0, false};
  for (int tl = loc; tl < PG * NT; tl += per) {
    const int pm = g0 + tl / NT, pn = tl % NT;
    if (last && pm * 256 >= ML && (pn < 1 || pn > 2)) continue;
    u32x4 ra[4], rb[4];
    gemm_tile<EPI_P, 4>(A, 1024, Bt, 1024, 1024, pm * 256, pn * 256, lds, P, layer, tid, ra, rb, false, none);
  }
}

DEVI void phase_rows(int wv, const Params& P, int layer, bool last, char* lds) {
  const int tid = otid(wv), wid = tid >> 6, lane = tid & 63;
  const int gw = blockIdx.x * (NTHR / 64) + wid, nw = gridDim.x * (NTHR / 64);
  const bfu* pbuf = reinterpret_cast<const bfu*>(P.ws + O_P);
  float* stats = reinterpret_cast<float*>(P.ws + O_STATS);
  const float* rt = reinterpret_cast<const float*>(P.ws + O_ROPE);
  bfu* Km = reinterpret_cast<bfu*>(P.ws + O_KM);
  bfu* Qg = reinterpret_cast<bfu*>(P.ws + O_QG);
  bfu* Kg = reinterpret_cast<bfu*>(P.ws + O_KG);
  bfu* Vg = reinterpret_cast<bfu*>(P.ws + O_VG);
  const float gq = P.gqa_q_norm[layer * 64 + lane], gk = P.gqa_k_norm[layer * 64 + lane];
  for (int row0 = gw; row0 < MT; row0 += 4 * nw) {
    u32x2 wq[4]; unsigned wkv[4]; bfu xq[4][6], xk[4][2], xvv[4][2], xkr[4]; float csg[4], sng[4], c2m[4], s2m[4];
#pragma unroll
    for (int q = 0; q < 4; ++q) {
      const int row = row0 + q * nw;
      if (row < MT) {
        int b, t, v; rowinfo(row, b, t, v);
        const bfu* pr = pbuf + (size_t)row * INC;
        wq[q] = *reinterpret_cast<const u32x2*>(pr + PC_MLAQ + lane * 4);
        wkv[q] = *reinterpret_cast<const unsigned*>(pr + PC_KV + lane * 2);
#pragma unroll
        for (int h = 0; h < 6; ++h) xq[q][h] = pr[PC_GQ + h * 64 + lane];
#pragma unroll
        for (int g = 0; g < 2; ++g) { xk[q][g] = pr[PC_GK + g * 64 + lane]; xvv[q][g] = pr[PC_GV + g * 64 + lane]; }
        xkr[q] = pr[PC_KR + (lane & 31)];
        csg[q] = 1.f; sng[q] = 0.f; c2m[q] = 1.f; s2m[q] = 0.f;
        if (row < ML) {
          { const int sec = lane >> 5, i = lane & 15; const int pos = sec ? (t & 63) : (t >> 6); csg[q] = rt[1024 + pos * 16 + i]; sng[q] = rt[2048 + pos * 16 + i]; }
          { const int e = lane & 31; const int sec = (e >> 4) & 1, i = e & 7; const int pos = sec ? (t & 63) : (t >> 6); c2m[q] = rt[pos * 8 + i]; s2m[q] = rt[512 + pos * 8 + i]; }
        }
      }
    }
#pragma unroll
    for (int q = 0; q < 4; ++q) {
      const int row = row0 + q * nw;
      if (row < MT) {
        int b, t, v; rowinfo(row, b, t, v);
        const bool latent = row < ML;
        {
          float a0 = bflo(wq[q][0]), a1 = bfhi(wq[q][0]), a2 = bflo(wq[q][1]), a3 = bfhi(wq[q][1]);
          float sq = wsum(a0 * a0 + a1 * a1 + a2 * a2 + a3 * a3);
          float c0 = bflo(wkv[q]), c1 = bfhi(wkv[q]);
          float sk = wsum(c0 * c0 + c1 * c1);
          if (lane == 0) { stats[row * 2] = rsqrtf(sq * (1.f / 256.f) + EPS); stats[row * 2 + 1] = rsqrtf(sk * (1.f / 128.f) + EPS); }
        }
        const float cs = csg[q], sn = sng[q];
        const bool firstg = !(lane & 16);
        if (latent || !last) {
#pragma unroll
          for (int h = 0; h < 6; ++h) {
            float x = bf2f(xq[q][h]);
            float ss = wsum(x * x);
            float xn = x * rsqrtf(ss * (1.f / 64.f) + EPS) * gq;
            float pn = swz_xor<16>(xn);
            float o = firstg ? (xn * cs - pn * sn) : (pn * sn + xn * cs);
            Qg[((size_t)(b * 6 + h) * TK + t) * 64 + lane] = f2bf(o * QS_G);
          }
        }
#pragma unroll
        for (int g = 0; g < 2; ++g) {
          float x = bf2f(xk[q][g]);
          float ss = wsum(x * x);
          float xn = x * rsqrtf(ss * (1.f / 64.f) + EPS) * gk;
          float pn = swz_xor<16>(xn);
          float o = firstg ? (xn * cs - pn * sn) : (pn * sn + xn * cs);
          Kg[((size_t)(b * 2 + g) * TK + t) * 64 + lane] = f2bf(o);
          Vg[((size_t)(b * 2 + g) * TK + t) * 64 + lane] = xvv[q][g];
        }
        {
          const int e = lane & 31;
          float x = bf2f(xkr[q]);
          float pn = swz_xor<8>(x);
          float o = !(e & 8) ? (x * c2m[q] - pn * s2m[q]) : (pn * s2m[q] + x * c2m[q]);
          const bfu ob = f2bf(o);
          const int hb = lane >> 5;
#pragma unroll
          for (int hh = 0; hh < 3; ++hh) Km[((size_t)(b * 6 + hh * 2 + hb) * TK + t) * 96 + 64 + e] = ob;
        }
      }
    }
  }
  float* yb = reinterpret_cast<float*>(lds);
  float* ob = yb + 62 * 256;
  bfu* z = reinterpret_cast<bfu*>(P.ws + O_Z);
  const int ntl = NB * 128, ntc = last ? 0 : NB * 8;
  const int c = tid & 255, hf = tid >> 8;
  for (int tile = blockIdx.x; tile < ntl + ntc; tile += gridDim.x) {
    int rowbase, seqlen, t0;
    if (tile < ntl) { const int b = tile >> 7; rowbase = b * SEQ; seqlen = SEQ; t0 = (tile & 127) * 32; }
    else { const int tt = tile - ntl; const int b = tt >> 3; rowbase = ML + b * CTX; seqlen = CTX; t0 = (tt & 7) * 32; }
    __syncthreads();
    for (int idx = tid; idx < 62 * 32; idx += NTHR) {
      const int tr = idx >> 5, ch = idx & 31, tt = t0 - 15 + tr;
      f32x4 o0 = {0.f, 0.f, 0.f, 0.f}, o1 = {0.f, 0.f, 0.f, 0.f};
      if (tt >= 0 && tt < seqlen) {
        const bfu* pr = pbuf + (size_t)(rowbase + tt) * INC + PC_CONV + ch * 8;
        u32x4 a = *reinterpret_cast<const u32x4*>(pr), g = *reinterpret_cast<const u32x4*>(pr + 256);
#pragma unroll
        for (int j = 0; j < 4; ++j) {
          float al = bflo(a[j]), ah = bfhi(a[j]), gl = bflo(g[j]), gh = bfhi(g[j]);
          float yl = al / (1.f + __expf(-gl)), yh = ah / (1.f + __expf(-gh));
          if (j < 2) { o0[j * 2] = yl; o0[j * 2 + 1] = yh; } else { o1[(j - 2) * 2] = yl; o1[(j - 2) * 2 + 1] = yh; }
        }
      }
      *reinterpret_cast<f32x4*>(yb + tr * 256 + ch * 8) = o0;
      *reinterpret_cast<f32x4*>(yb + tr * 256 + ch * 8 + 4) = o1;
    }
    __syncthreads();
    {
      float acc[16];
      const float bias = P.conv_dw_b[layer * 256 + c];
#pragma unroll
      for (int i = 0; i < 16; ++i) acc[i] = bias;
      const float* wp = P.conv_dw_w + (size_t)layer * 31 * 256 + c;
      const float* yp = yb + (hf * 16) * 256 + c;
#pragma unroll
      for (int j = 0; j < 46; ++j) {
        const float yv = yp[j * 256];
#pragma unroll
        for (int i = 0; i < 16; ++i) {
          const int tap = j - i;
          if (tap >= 0 && tap < 31) acc[i] += wp[tap * 256] * yv;
        }
      }
#pragma unroll
      for (int i = 0; i < 16; ++i) ob[(hf * 16 + i) * 256 + c] = acc[i];
    }
    __syncthreads();
    {
      const f32x4 lw = *reinterpret_cast<const f32x4*>(P.conv_ln_w + layer * 256 + lane * 4);
      const f32x4 lb = *reinterpret_cast<const f32x4*>(P.conv_ln_b + layer * 256 + lane * 4);
#pragma unroll
      for (int q = 0; q < 4; ++q) {
        const int tok = wid * 4 + q;
        f32x4 v = *reinterpret_cast<const f32x4*>(ob + tok * 256 + lane * 4);
        const float mu = wsum(v[0] + v[1] + v[2] + v[3]) * (1.f / 256.f);
        const float d0 = v[0] - mu, d1 = v[1] - mu, d2 = v[2] - mu, d3 = v[3] - mu;
        const float var = wsum(d0 * d0 + d1 * d1 + d2 * d2 + d3 * d3) * (1.f / 256.f);
        const float rs = rsqrtf(var + EPS);
        const float n0 = siluf(d0 * rs * lw[0] + lb[0]), n1 = siluf(d1 * rs * lw[1] + lb[1]), n2 = siluf(d2 * rs * lw[2] + lb[2]), n3 = siluf(d3 * rs * lw[3] + lb[3]);
        u32x2 w = {pk2(n0, n1), pk2(n2, n3)};
        *reinterpret_cast<u32x2*>(z + (size_t)(rowbase + t0 + tok) * 256 + lane * 4) = w;
      }
    }
  }
  __syncthreads();
}

DEVI void phase_gemm_mid(int wv, const Params& P, int layer, bool last, char* lds) {
  const int tid = otid(wv);
  const bfu* pbuf = reinterpret_cast<const bfu*>(P.ws + O_P);
  const bfu* Wuq = reinterpret_cast<const bfu*>(P.ws + O_WUQ + layer * SZ_WUQ);
  const bfu* Wukv = reinterpret_cast<const bfu*>(P.ws + O_WUKV + layer * SZ_WUKV);
  const bfu* Wpw = reinterpret_cast<const bfu*>(P.ws + O_WPW + layer * SZ_WPW);
  const bfu* z = reinterpret_cast<const bfu*>(P.ws + O_Z);
  constexpr int PANELS = MT / 256, SUB = 13;
  int grp, loc, per, ngrp; blk_group(grp, loc, per, ngrp);
  const int PG = PANELS / ngrp, g0 = grp * PG;
  const NextTile none{nullptr, nullptr, 0, 0, 0, 0, false};
  for (int tl = loc; tl < PG * SUB; tl += per) {
    const int pm = g0 + tl / SUB, sub = tl % SUB, m0 = pm * 256;
    const bool ctxp = m0 >= ML;
    u32x4 ra[4], rb[2];
    if (sub < 5) { if (!(last && ctxp)) gemm_tile<EPI_Q, 2>(pbuf + PC_MLAQ, INC, Wuq, 256, 256, m0, sub * 128, lds, P, layer, tid, ra, rb, false, none); }
    else if (sub < 11) gemm_tile<EPI_KV, 2>(pbuf + PC_KV, INC, Wukv, 128, 128, m0, (sub - 5) * 128, lds, P, layer, tid, ra, rb, false, none);
    else { if (!(last && ctxp)) gemm_tile<EPI_CONV, 2>(z, 256, Wpw, 256, 256, m0, (sub - 11) * 128, lds, P, layer, tid, ra, rb, false, none); }
  }
}

DEVI int v_st(int k, int c) { return ((k >> 3) * 2 + (c >> 5)) * 512 + ((k & 7) * 32 + (c & 31)) * 2; }
DEVI int v_rd_base(int lane) { return ((lane & 3) << 3) | (((lane >> 2) & 3) << 6) | (((lane >> 4) & 1) << 5) | (((lane >> 5) & 1) << 8); }
constexpr int v_rd_off(int d0, int ks, int half) { return d0 * 512 + ks * 2048 + half * 1024; }
template <int OFF> DEVI s16x4 tr_read(int vb) {
  s16x4 r; asm volatile("ds_read_b64_tr_b16 %0, %1 offset:%2" : "=&v"(r) : "v"(vb), "i"(OFF) : "memory"); return r;
}
#define SBAR() __builtin_amdgcn_sched_barrier(0)

DEVI void pv_all(f32x16& oa, f32x16& ob, int vb, bf16x8 pa0, bf16x8 pa1, bf16x8 pa2, bf16x8 pa3) {
#define PK(L, H) (bf16x8){L[0], L[1], L[2], L[3], H[0], H[1], H[2], H[3]}
  const s16x4 a0 = tr_read<v_rd_off(0, 0, 0)>(vb), b0 = tr_read<v_rd_off(0, 0, 1)>(vb), c0 = tr_read<v_rd_off(1, 0, 0)>(vb), d0 = tr_read<v_rd_off(1, 0, 1)>(vb);
  const s16x4 a1 = tr_read<v_rd_off(0, 1, 0)>(vb), b1 = tr_read<v_rd_off(0, 1, 1)>(vb), c1 = tr_read<v_rd_off(1, 1, 0)>(vb), d1 = tr_read<v_rd_off(1, 1, 1)>(vb);
  const s16x4 a2 = tr_read<v_rd_off(0, 2, 0)>(vb), b2 = tr_read<v_rd_off(0, 2, 1)>(vb), c2 = tr_read<v_rd_off(1, 2, 0)>(vb), d2 = tr_read<v_rd_off(1, 2, 1)>(vb);
  const s16x4 a3 = tr_read<v_rd_off(0, 3, 0)>(vb), b3 = tr_read<v_rd_off(0, 3, 1)>(vb), c3 = tr_read<v_rd_off(1, 3, 0)>(vb), d3 = tr_read<v_rd_off(1, 3, 1)>(vb);
  asm volatile("s_waitcnt lgkmcnt(0)" ::: "memory"); SBAR();
  oa = mfma32(PK(a0, b0), pa0, oa); ob = mfma32(PK(c0, d0), pa0, ob);
  oa = mfma32(PK(a1, b1), pa1, oa); ob = mfma32(PK(c1, d1), pa1, ob);
  oa = mfma32(PK(a2, b2), pa2, oa); ob = mfma32(PK(c2, d2), pa2, ob);
  oa = mfma32(PK(a3, b3), pa3, oa); ob = mfma32(PK(c3, d3), pa3, ob);
#undef PK
}

template <bool FAST> DEVI void partialSM(f32x16& p0, f32x16& p1, float& m_reg, float& alpha) {
  if constexpr (FAST) { alpha = 1.f; return; }
  float pmax = p0[0];
#pragma unroll
  for (int r = 1; r < 16; ++r) pmax = fmaxf(pmax, p0[r]);
#pragma unroll
  for (int r = 0; r < 16; ++r) pmax = fmaxf(pmax, p1[r]);
  { auto rr = __builtin_amdgcn_permlane32_swap(__float_as_uint(pmax), __float_as_uint(pmax), false, false);
    pmax = fmaxf(__uint_as_float(rr[0]), __uint_as_float(rr[1])); }
  if (__all(pmax <= m_reg)) { alpha = 1.f; }
  else { const float mn = fmaxf(m_reg, pmax); alpha = __builtin_amdgcn_exp2f(m_reg - mn); m_reg = mn; }
#pragma unroll
  for (int r = 0; r < 16; ++r) p0[r] = __builtin_amdgcn_exp2f(p0[r] - m_reg);
#pragma unroll
  for (int r = 0; r < 16; ++r) p1[r] = p1[r] - m_reg;
}
template <bool FAST> DEVI void finishSM(f32x16& p0, f32x16& p1, float alpha, float& l_reg, bf16x8& pa0, bf16x8& pa1, bf16x8& pa2, bf16x8& pa3) {
  if constexpr (FAST) {
#pragma unroll
    for (int r = 0; r < 16; ++r) p0[r] = __builtin_amdgcn_exp2f(p0[r]);
  }
#pragma unroll
  for (int r = 0; r < 16; ++r) p1[r] = __builtin_amdgcn_exp2f(p1[r]);
  float ps = 0.f;
#pragma unroll
  for (int r = 0; r < 16; ++r) ps += p0[r];
#pragma unroll
  for (int r = 0; r < 16; ++r) ps += p1[r];
  if constexpr (FAST) { l_reg += ps; }
  else {
  { auto rr = __builtin_amdgcn_permlane32_swap(__float_as_uint(ps), __float_as_uint(ps), false, false);
    ps = __uint_as_float(rr[0]) + __uint_as_float(rr[1]); }
  l_reg = l_reg * alpha + ps;
  }
#define PK8(P, BASE, OUT) do { u32x4 w = {cvtpk(P[BASE + 0], P[BASE + 1]), cvtpk(P[BASE + 2], P[BASE + 3]), cvtpk(P[BASE + 4], P[BASE + 5]), cvtpk(P[BASE + 6], P[BASE + 7])}; \
    OUT = *reinterpret_cast<bf16x8*>(&w); } while (0)
  PK8(p0, 0, pa0); PK8(p0, 8, pa1); PK8(p1, 0, pa2); PK8(p1, 8, pa3);
#undef PK8
}

template <int DQK>
DEVI void qkt(f32x16& p0, f32x16& p1, const char* Ks, const bf16x8* qr, int r32, int hi) {
  constexpr int KROW = DQK * 2 + 16, ND = DQK / 16;
#pragma unroll
  for (int r = 0; r < 16; ++r) { p0[r] = 0.f; p1[r] = 0.f; }
  const char* ka = Ks + r32 * KROW + hi * 16;
  const char* kb = Ks + (32 + r32) * KROW + hi * 16;
  bf16x8 x0 = *reinterpret_cast<const bf16x8*>(ka), x1 = *reinterpret_cast<const bf16x8*>(kb), y0, y1;
#pragma unroll
  for (int d0 = 0; d0 < ND; d0 += 2) {
    if (d0 + 1 < ND) { y0 = *reinterpret_cast<const bf16x8*>(ka + (d0 + 1) * 32); y1 = *reinterpret_cast<const bf16x8*>(kb + (d0 + 1) * 32); }
    SBAR();
    p0 = mfma32(x0, qr[d0], p0); p1 = mfma32(x1, qr[d0], p1);
    SBAR();
    if (d0 + 1 < ND) {
      if (d0 + 2 < ND) { x0 = *reinterpret_cast<const bf16x8*>(ka + (d0 + 2) * 32); x1 = *reinterpret_cast<const bf16x8*>(kb + (d0 + 2) * 32); }
      SBAR();
      p0 = mfma32(y0, qr[d0 + 1], p0); p1 = mfma32(y1, qr[d0 + 1], p1);
      SBAR();
    }
  }
}

template <int DQK, bool FAST>
DEVI bool attn_unit(const bfu* __restrict__ Q, const bfu* __restrict__ Kh, const bfu* __restrict__ Vh, int nkeys,
                    const bfu* __restrict__ pg, bfu* __restrict__ yo, char* lds, int tid) {
  constexpr int KROW = DQK * 2 + 16, KT_BYTES = 64 * KROW, VT_BYTES = 8192, KCH = 64 * (DQK / 8);
  constexpr int CPR = DQK / 8;
  const int wid = tid >> 6, lane = tid & 63, r32 = lane & 31, hi = lane >> 5;
  char* K_lds = lds; char* V_lds = lds + 3 * KT_BYTES;
  float m_reg = -1e30f, l_reg = 0.f;
  f32x16 o0, o1;
#pragma unroll
  for (int r = 0; r < 16; ++r) { o0[r] = 0.f; o1[r] = 0.f; }
  bf16x8 qr[DQK / 16];
  {
    const bfu* Qw = Q + (size_t)(wid * 32 + r32) * DQK + hi * 8;
#pragma unroll
    for (int d0 = 0; d0 < DQK / 16; ++d0) qr[d0] = *reinterpret_cast<const bf16x8*>(Qw + d0 * 16);
  }
  const bool k2 = (tid + 512) < KCH;
  const int kq0 = tid, kq1 = tid + 512;
  const int kst0 = (kq0 / CPR) * KROW + (kq0 % CPR) * 16, kst1 = (kq1 / CPR) * KROW + (kq1 % CPR) * 16;
  const int vst = v_st(tid >> 3, (tid & 7) * 8);
  const int vb0 = (int)(uintptr_t)V_lds + v_rd_base(lane);
  u32x4 sk0, sk1, sv;
  sk1 = u32x4{0u, 0u, 0u, 0u};
#define SLOAD(kt) do { const bfu* kp_ = Kh + (size_t)(kt) * 64 * DQK; sk0 = *reinterpret_cast<const u32x4*>(kp_ + kq0 * 8); \
    if (k2) sk1 = *reinterpret_cast<const u32x4*>(kp_ + kq1 * 8); sv = *reinterpret_cast<const u32x4*>(Vh + (size_t)(kt) * 64 * 64 + tid * 8); } while (0)
#define SWRITE(s) do { *reinterpret_cast<u32x4*>(K_lds + (s) * KT_BYTES + kst0) = sk0; if (k2) *reinterpret_cast<u32x4*>(K_lds + (s) * KT_BYTES + kst1) = sk1; \
    *reinterpret_cast<u32x4*>(V_lds + (s) * VT_BYTES + vst) = sv; } while (0)
#define RESC(a) do { if constexpr (!FAST) if (__any((a) < 1.f)) { _Pragma("unroll") for (int r = 0; r < 16; ++r) { o0[r] *= (a); o1[r] *= (a); } } } while (0)
  f32x16 pA0, pA1, pB0, pB1; float alA, alB; bf16x8 pa0, pa1, pa2, pa3;
  const int NT = nkeys / 64;
  __syncthreads();
  SLOAD(0); SWRITE(0); SLOAD(1);
  __syncthreads();
  SWRITE(1); SLOAD(2);
  qkt<DQK>(pA0, pA1, K_lds, qr, r32, hi); partialSM<FAST>(pA0, pA1, m_reg, alA);
  __syncthreads();
  int sa = 0, sb = 1, sc = 2;
  for (int j = 1; j + 1 < NT; j += 2) {
    SWRITE(sc); if (j + 2 < NT) SLOAD(j + 2);
    SBAR(); qkt<DQK>(pB0, pB1, K_lds + sb * KT_BYTES, qr, r32, hi); if constexpr (FAST) SBAR();
    finishSM<FAST>(pA0, pA1, alA, l_reg, pa0, pa1, pa2, pa3); SBAR();
    pv_all(o0, o1, vb0 + sa * VT_BYTES, pa0, pa1, pa2, pa3);
    partialSM<FAST>(pB0, pB1, m_reg, alB); RESC(alB);
    __syncthreads();
    SWRITE(sa); if (j + 3 < NT) SLOAD(j + 3);
    SBAR(); qkt<DQK>(pA0, pA1, K_lds + sc * KT_BYTES, qr, r32, hi); if constexpr (FAST) SBAR();
    finishSM<FAST>(pB0, pB1, alB, l_reg, pa0, pa1, pa2, pa3); SBAR();
    pv_all(o0, o1, vb0 + sb * VT_BYTES, pa0, pa1, pa2, pa3);
    partialSM<FAST>(pA0, pA1, m_reg, alA); RESC(alA);
    __syncthreads();
    { const int t_ = sa; sa = sc; sc = sb; sb = t_; }
  }
  SBAR(); qkt<DQK>(pB0, pB1, K_lds + sb * KT_BYTES, qr, r32, hi);
  finishSM<FAST>(pA0, pA1, alA, l_reg, pa0, pa1, pa2, pa3); SBAR();
  pv_all(o0, o1, vb0 + sa * VT_BYTES, pa0, pa1, pa2, pa3);
  partialSM<FAST>(pB0, pB1, m_reg, alB); RESC(alB);
  finishSM<FAST>(pB0, pB1, alB, l_reg, pa0, pa1, pa2, pa3); SBAR();
  pv_all(o0, o1, vb0 + sb * VT_BYTES, pa0, pa1, pa2, pa3);
#undef SLOAD
#undef SWRITE
#undef RESC
  if constexpr (FAST) {
    { auto rr = __builtin_amdgcn_permlane32_swap(__float_as_uint(l_reg), __float_as_uint(l_reg), false, false);
      l_reg = __uint_as_float(rr[0]) + __uint_as_float(rr[1]); }
    const int bad = !(l_reg > 1e-30f && l_reg < 1e30f);
    const int wbad = __any(bad) ? 1 : 0;
    __syncthreads();
    if (lane == 0) reinterpret_cast<int*>(lds)[wid] = wbad;
    __syncthreads();
    int anyb = 0;
#pragma unroll
    for (int w = 0; w < NTHR / 64; ++w) anyb |= reinterpret_cast<const int*>(lds)[w];
    if (anyb) return false;
  }
  const float inv = 1.f / l_reg;
  const int qrow = wid * 32 + r32;
  const bfu* pgr = pg + (size_t)qrow * INC;
  bfu* yr = yo + (size_t)qrow * 1024;
#pragma unroll
  for (int g4 = 0; g4 < 4; ++g4) {
    const int cbase = 8 * g4 + 4 * hi;
    {
      u32x2 gw = *reinterpret_cast<const u32x2*>(pgr + cbase);
      float a0 = o0[g4 * 4 + 0] * inv * siluf(bflo(gw[0])), a1 = o0[g4 * 4 + 1] * inv * siluf(bfhi(gw[0]));
      float a2 = o0[g4 * 4 + 2] * inv * siluf(bflo(gw[1])), a3 = o0[g4 * 4 + 3] * inv * siluf(bfhi(gw[1]));
      u32x2 w = {pk2(a0, a1), pk2(a2, a3)};
      *reinterpret_cast<u32x2*>(yr + cbase) = w;
    }
    {
      u32x2 gw = *reinterpret_cast<const u32x2*>(pgr + 32 + cbase);
      float a0 = o1[g4 * 4 + 0] * inv * siluf(bflo(gw[0])), a1 = o1[g4 * 4 + 1] * inv * siluf(bfhi(gw[0]));
      float a2 = o1[g4 * 4 + 2] * inv * siluf(bflo(gw[1])), a3 = o1[g4 * 4 + 3] * inv * siluf(bfhi(gw[1]));
      u32x2 w = {pk2(a0, a1), pk2(a2, a3)};
      *reinterpret_cast<u32x2*>(yr + 32 + cbase) = w;
    }
  }
  return true;
}

template <int DQK>
DEVI bool attn_unit_ks(const bfu* __restrict__ Q, const bfu* __restrict__ Kh, const bfu* __restrict__ Vh, int nkeys,
                       const bfu* __restrict__ pg, bfu* __restrict__ yo, char* lds, int tid) {
  constexpr int KROW = DQK * 2 + 16, KT_BYTES = 64 * KROW, VT_BYTES = 8192, KCH = 64 * (DQK / 8), CPR = DQK / 8, ND = DQK / 16;
  const int wid = tid >> 6, lane = tid & 63, r32 = lane & 31, hi = lane >> 5;
  const int qg = wid >> 1, kh = wid & 1;
  char* K_lds = lds; char* V_lds = lds + 3 * KT_BYTES;
  float l0 = 0.f, l1 = 0.f;
  f32x16 o00, o01, o10, o11;
#pragma unroll
  for (int r = 0; r < 16; ++r) { o00[r] = 0.f; o01[r] = 0.f; o10[r] = 0.f; o11[r] = 0.f; }
  bf16x8 qa[ND], qb[ND];
  {
    const bfu* Qw = Q + (size_t)(qg * 64 + r32) * DQK + hi * 8;
#pragma unroll
    for (int d0 = 0; d0 < ND; ++d0) { qa[d0] = *reinterpret_cast<const bf16x8*>(Qw + d0 * 16); qb[d0] = *reinterpret_cast<const bf16x8*>(Qw + 32 * DQK + d0 * 16); }
  }
  const bool k2 = (tid + 512) < KCH;
  const int kq0 = tid, kq1 = tid + 512;
  const int kst0 = (kq0 / CPR) * KROW + (kq0 % CPR) * 16, kst1 = (kq1 / CPR) * KROW + (kq1 % CPR) * 16;
  const int vst = v_st(tid >> 3, (tid & 7) * 8);
  const int vb0 = (int)(uintptr_t)V_lds + kh * 4096 + v_rd_base(lane);
  const int kfo = (kh * 32 + r32) * KROW + hi * 16;
  u32x4 sk0, sk1, sv;
  sk1 = u32x4{0u, 0u, 0u, 0u};
  const unsigned ko0 = (unsigned)kq0 * 16u, ko1 = (unsigned)kq1 * 16u, vo0 = (unsigned)tid * 16u;
#define SLOAD(kt) do { const char* kp_ = reinterpret_cast<const char*>(Kh) + (size_t)(kt) * (64 * DQK * 2); sk0 = *reinterpret_cast<const u32x4*>(kp_ + ko0); \
    if (k2) sk1 = *reinterpret_cast<const u32x4*>(kp_ + ko1); sv = *reinterpret_cast<const u32x4*>(reinterpret_cast<const char*>(Vh) + (size_t)(kt) * (64 * 64 * 2) + vo0); } while (0)
#define SWRITE(s) do { *reinterpret_cast<u32x4*>(K_lds + (s) * KT_BYTES + kst0) = sk0; if (k2) *reinterpret_cast<u32x4*>(K_lds + (s) * KT_BYTES + kst1) = sk1; \
    *reinterpret_cast<u32x4*>(V_lds + (s) * VT_BYTES + vst) = sv; } while (0)
  const int NT = nkeys / 64;
  __syncthreads();
  SLOAD(0); SWRITE(0); SLOAD(1);
  __syncthreads();
  int slot = 0, wslot = 1;
  for (int j = 0; j < NT; ++j) {
    if (j + 1 < NT) SWRITE(wslot);
    if (j + 2 < NT) SLOAD(j + 2);
    f32x16 pA, pB;
#pragma unroll
    for (int r = 0; r < 16; ++r) { pA[r] = 0.f; pB[r] = 0.f; }
    {
      const char* kp = K_lds + slot * KT_BYTES + kfo;
#pragma unroll
      for (int d0 = 0; d0 < ND; ++d0) {
        const bf16x8 kx = *reinterpret_cast<const bf16x8*>(kp + d0 * 32);
        pA = mfma32(kx, qa[d0], pA); pB = mfma32(kx, qb[d0], pB);
      }
    }
    float psA = 0.f, psB = 0.f;
#pragma unroll
    for (int r = 0; r < 16; ++r) { pA[r] = __builtin_amdgcn_exp2f(pA[r]); pB[r] = __builtin_amdgcn_exp2f(pB[r]); }
#pragma unroll
    for (int r = 0; r < 16; ++r) { psA += pA[r]; psB += pB[r]; }
    l0 += psA; l1 += psB;
    bf16x8 fA0, fA1, fB0, fB1;
#define PK8(P, BASE, OUT) do { u32x4 w = {cvtpk(P[BASE + 0], P[BASE + 1]), cvtpk(P[BASE + 2], P[BASE + 3]), cvtpk(P[BASE + 4], P[BASE + 5]), cvtpk(P[BASE + 6], P[BASE + 7])}; \
    OUT = *reinterpret_cast<bf16x8*>(&w); } while (0)
    PK8(pA, 0, fA0); PK8(pA, 8, fA1); PK8(pB, 0, fB0); PK8(pB, 8, fB1);
#undef PK8
    SBAR();
    {
      const int vb = vb0 + slot * VT_BYTES;
#define PK(L, H) (bf16x8){L[0], L[1], L[2], L[3], H[0], H[1], H[2], H[3]}
      {
        const s16x4 a0 = tr_read<v_rd_off(0, 0, 0)>(vb), b0 = tr_read<v_rd_off(0, 0, 1)>(vb), c0 = tr_read<v_rd_off(1, 0, 0)>(vb), d0_ = tr_read<v_rd_off(1, 0, 1)>(vb);
        asm volatile("s_waitcnt lgkmcnt(0)" ::: "memory"); SBAR();
        const bf16x8 v00 = PK(a0, b0), v10 = PK(c0, d0_);
        o00 = mfma32(v00, fA0, o00); o01 = mfma32(v10, fA0, o01); o10 = mfma32(v00, fB0, o10); o11 = mfma32(v10, fB0, o11);
      }
      SBAR();
      {
        const s16x4 a1 = tr_read<v_rd_off(0, 1, 0)>(vb), b1 = tr_read<v_rd_off(0, 1, 1)>(vb), c1 = tr_read<v_rd_off(1, 1, 0)>(vb), d1_ = tr_read<v_rd_off(1, 1, 1)>(vb);
        asm volatile("s_waitcnt lgkmcnt(0)" ::: "memory"); SBAR();
        const bf16x8 v01 = PK(a1, b1), v11 = PK(c1, d1_);
        o00 = mfma32(v01, fA1, o00); o01 = mfma32(v11, fA1, o01); o10 = mfma32(v01, fB1, o10); o11 = mfma32(v11, fB1, o11);
      }
#undef PK
    }
    __syncthreads();
    slot = (slot == 2) ? 0 : slot + 1; wslot = (wslot == 2) ? 0 : wslot + 1;
  }
#undef SLOAD
#undef SWRITE
  float* cbuf = reinterpret_cast<float*>(lds);
  float* mine = cbuf + wid * (33 * 64) + lane;
  const float* theirs = cbuf + (wid ^ 1) * (33 * 64) + lane;
  f32x16 o0, o1; float l_reg;
  if (kh) {
#pragma unroll
    for (int r = 0; r < 16; ++r) { mine[r * 64] = o00[r]; mine[(16 + r) * 64] = o01[r]; }
    mine[32 * 64] = l0;
    o0 = o10; o1 = o11; l_reg = l1;
  } else {
#pragma unroll
    for (int r = 0; r < 16; ++r) { mine[r * 64] = o10[r]; mine[(16 + r) * 64] = o11[r]; }
    mine[32 * 64] = l1;
    o0 = o00; o1 = o01; l_reg = l0;
  }
  __syncthreads();
#pragma unroll
  for (int r = 0; r < 16; ++r) { o0[r] += theirs[r * 64]; o1[r] += theirs[(16 + r) * 64]; }
  l_reg += theirs[32 * 64];
  { auto rr = __builtin_amdgcn_permlane32_swap(__float_as_uint(l_reg), __float_as_uint(l_reg), false, false);
    l_reg = __uint_as_float(rr[0]) + __uint_as_float(rr[1]); }
  {
    const int bad = !(l_reg > 1e-30f && l_reg < 1e30f);
    const int wbad = __any(bad) ? 1 : 0;
    __syncthreads();
    if (lane == 0) reinterpret_cast<int*>(lds)[wid] = wbad;
    __syncthreads();
    int anyb = 0;
#pragma unroll
    for (int w = 0; w < NTHR / 64; ++w) anyb |= reinterpret_cast<const int*>(lds)[w];
    if (anyb) return false;
  }
  const float inv = 1.f / l_reg;
  int qrow = qg * 64 + kh * 32 + r32;
  asm volatile("" : "+v"(qrow));
  const bfu* pgr = pg + (size_t)qrow * INC;
  bfu* yr = yo + (size_t)qrow * 1024;
#pragma unroll
  for (int g4 = 0; g4 < 4; ++g4) {
    const int cbase = 8 * g4 + 4 * hi;
    {
      u32x2 gw = *reinterpret_cast<const u32x2*>(pgr + cbase);
      float a0 = o0[g4 * 4 + 0] * inv * siluf(bflo(gw[0])), a1 = o0[g4 * 4 + 1] * inv * siluf(bfhi(gw[0]));
      float a2 = o0[g4 * 4 + 2] * inv * siluf(bflo(gw[1])), a3 = o0[g4 * 4 + 3] * inv * siluf(bfhi(gw[1]));
      u32x2 w = {pk2(a0, a1), pk2(a2, a3)};
      *reinterpret_cast<u32x2*>(yr + cbase) = w;
    }
    {
      u32x2 gw = *reinterpret_cast<const u32x2*>(pgr + 32 + cbase);
      float a0 = o1[g4 * 4 + 0] * inv * siluf(bflo(gw[0])), a1 = o1[g4 * 4 + 1] * inv * siluf(bfhi(gw[0]));
      float a2 = o1[g4 * 4 + 2] * inv * siluf(bflo(gw[1])), a3 = o1[g4 * 4 + 3] * inv * siluf(bfhi(gw[1]));
      u32x2 w = {pk2(a0, a1), pk2(a2, a3)};
      *reinterpret_cast<u32x2*>(yr + 32 + cbase) = w;
    }
  }
  return true;
}

template <bool FAST> DEVI bool attn_dispatch(const Params& P, int b, int head12, int qb, bool ctxq, char* lds, int tid) {
  const bfu* pbuf = reinterpret_cast<const bfu*>(P.ws + O_P);
  bfu* yb = reinterpret_cast<bfu*>(P.ws + O_H);
  const int t0 = ctxq ? SEQ : qb * 256;
  const int row0 = ctxq ? ML + b * CTX : b * SEQ + qb * 256;
  const int kt0 = ctxq ? SEQ : 0, nkeys = ctxq ? CTX : TK;
  if (head12 < 6) {
    const int h = head12;
    const bfu* Q = reinterpret_cast<const bfu*>(P.ws + O_QM) + ((size_t)(b * 6 + h) * TK + t0) * 96;
    const bfu* K = reinterpret_cast<const bfu*>(P.ws + O_KM) + ((size_t)(b * 6 + h) * TK + kt0) * 96;
    const bfu* V = reinterpret_cast<const bfu*>(P.ws + O_VM) + ((size_t)(b * 6 + h) * TK + kt0) * 64;
    return attn_unit<96, FAST>(Q, K, V, nkeys, pbuf + (size_t)row0 * INC + PC_GATE + h * 64, yb + (size_t)row0 * 1024 + h * 64, lds, tid);
  } else {
    const int h = head12 - 6, g = h / 3;
    const bfu* Q = reinterpret_cast<const bfu*>(P.ws + O_QG) + ((size_t)(b * 6 + h) * TK + t0) * 64;
    const bfu* K = reinterpret_cast<const bfu*>(P.ws + O_KG) + ((size_t)(b * 2 + g) * TK + kt0) * 64;
    const bfu* V = reinterpret_cast<const bfu*>(P.ws + O_VG) + ((size_t)(b * 2 + g) * TK + kt0) * 64;
    if constexpr (FAST) return attn_unit_ks<64>(Q, K, V, nkeys, pbuf + (size_t)row0 * INC + PC_GATE + 384 + h * 64, yb + (size_t)row0 * 1024 + 384 + h * 64, lds, tid);
    else return attn_unit<64, false>(Q, K, V, nkeys, pbuf + (size_t)row0 * INC + PC_GATE + 384 + h * 64, yb + (size_t)row0 * 1024 + 384 + h * 64, lds, tid);
  }
}

template <bool FAST> DEVI unsigned phase_attn(int wv, const Params& P, bool last, char* lds, unsigned mask) {
  const int tid = otid(wv);
  int grp, loc, per, ngrp; blk_group(grp, loc, per, ngrp);
  const int UL = (NB / ngrp) * 192, UC = last ? 0 : (NB / ngrp) * 12;
  unsigned bad = 0u; int k = 0;
  for (int u = loc; u < UL + UC; u += per, ++k) {
    if (!FAST && !((mask >> (k & 31)) & 1u)) continue;
    bool ok;
    if (u < UL) { const int ug = grp * UL + u; ok = attn_dispatch<FAST>(P, ug / 192, (ug % 192) >> 4, ug & 15, false, lds, tid); }
    else { const int ug = grp * UC + (u - UL); ok = attn_dispatch<FAST>(P, ug / 12, ug % 12, 0, true, lds, tid); }
    if (!ok) bad |= 1u << (k & 31);
  }
  return bad;
}

DEVI void phase_gemm_out(int wv, const Params& P, int layer, bool last, char* lds) {
  const int tid = otid(wv);
  const bfu* A = reinterpret_cast<const bfu*>(P.ws + O_H);
  const bfu* Bt = reinterpret_cast<const bfu*>(P.ws + O_WOUT + layer * SZ_WOUT);
  const int PANELS = last ? ML / 256 : MT / 256;
  constexpr int NT = 8;
  int grp, loc, per, ngrp; blk_group(grp, loc, per, ngrp);
  const int PG = PANELS / ngrp, g0 = grp * PG;
  u32x4 ra[4], rb[2]; bool pref = false;
  for (int tl = loc; tl < PG * NT; tl += per) {
    const int tn = tl + per;
    NextTile nx{A, Bt, 1024, 1024, (g0 + tn / NT) * 256, (tn % NT) * 128, tn < PG * NT};
    gemm_tile<EPI_OUT, 2>(A, 1024, Bt, 1024, 1024, (g0 + tl / NT) * 256, (tl % NT) * 128, lds, P, layer, tid, ra, rb, pref, nx);
    pref = nx.valid;
  }
}

DEVI void phase_final(int wv, const Params& P) {
  const int tid = otid(wv), wid = tid >> 6, lane = tid & 63;
  const int gw = blockIdx.x * (NTHR / 64) + wid, nw = gridDim.x * (NTHR / 64);
  f32x4 gw4[4];
#pragma unroll
  for (int i = 0; i < 4; ++i) gw4[i] = *reinterpret_cast<const f32x4*>(P.final_norm_w + (i * 64 + lane) * 4);
  const bfu* dbuf = reinterpret_cast<const bfu*>(P.ws + O_D);
  const float* mod1 = reinterpret_cast<const float*>(P.ws + O_MOD) + (size_t)9 * 3072;
  for (int row0 = gw; row0 < ML; row0 += 4 * nw) {
    f32x4 xv[4][4]; u32x2 dv[4][4];
#pragma unroll
    for (int q = 0; q < 4; ++q) {
      const int row = row0 + q * nw;
      if (row < ML) {
#pragma unroll
        for (int i = 0; i < 4; ++i) { xv[q][i] = *reinterpret_cast<const f32x4*>(P.out + (size_t)row * 1024 + (i * 64 + lane) * 4);
          dv[q][i] = *reinterpret_cast<const u32x2*>(dbuf + (size_t)row * 1024 + (i * 64 + lane) * 4); }
      }
    }
#pragma unroll
    for (int q = 0; q < 4; ++q) {
      const int row = row0 + q * nw;
      if (row < ML) {
#pragma unroll
        for (int i = 0; i < 4; ++i) {
          const f32x4 g1 = *reinterpret_cast<const f32x4*>(mod1 + (size_t)(row >> 12) * 3072 + 2048 + (i * 64 + lane) * 4);
          xv[q][i][0] += g1[0] * bflo(dv[q][i][0]); xv[q][i][1] += g1[1] * bfhi(dv[q][i][0]);
          xv[q][i][2] += g1[2] * bflo(dv[q][i][1]); xv[q][i][3] += g1[3] * bfhi(dv[q][i][1]);
        }
        float ss = 0.f;
#pragma unroll
        for (int i = 0; i < 4; ++i) ss += xv[q][i][0] * xv[q][i][0] + xv[q][i][1] * xv[q][i][1] + xv[q][i][2] * xv[q][i][2] + xv[q][i][3] * xv[q][i][3];
        ss = wsum(ss);
        const float r = rsqrtf(ss * (1.f / 1024.f) + EPS);
#pragma unroll
        for (int i = 0; i < 4; ++i) {
          f32x4 o = {xv[q][i][0] * r * gw4[i][0], xv[q][i][1] * r * gw4[i][1], xv[q][i][2] * r * gw4[i][2], xv[q][i][3] * r * gw4[i][3]};
          *reinterpret_cast<f32x4*>(P.out + (size_t)row * 1024 + (i * 64 + lane) * 4) = o;
        }
      }
    }
  }
}

DEVI bool is_t0(int wv) { return wv == 0 && __builtin_amdgcn_mbcnt_hi(~0u, __builtin_amdgcn_mbcnt_lo(~0u, 0u)) == 0u; }
#define XB_TMO      128
#define XB_XCNT(j)  (256  + 64 * (j))
#define XB_XSUB(j)  (1280 + 64 * (j))
#define XB_XGEN(j)  (2304 + 64 * (j))
#define XB_TOP      3328
#define XB_TOPGEN   3392
#define XB_SPIN_CAP (1u << 18)
#define LAS __attribute__((address_space(3)))
DEVI unsigned xb_ld(unsigned* p)              { return __hip_atomic_load(p, __ATOMIC_RELAXED, __HIP_MEMORY_SCOPE_AGENT); }
DEVI unsigned xb_add(unsigned* p, unsigned v) { return __hip_atomic_fetch_add(p, v, __ATOMIC_RELAXED, __HIP_MEMORY_SCOPE_AGENT); }
DEVI unsigned xb_xcc_id() { return (unsigned)__builtin_amdgcn_s_getreg((3 << 11) | 20) & 0xFu; }
#define XB_SPIN(cond, bar) do { unsigned _sp = 0; while (cond) { __builtin_amdgcn_s_sleep(1); \
    if ((++_sp & 255u) == 0u) { if (xb_ld(&(bar)[XB_TMO])) break; if (_sp > XB_SPIN_CAP) { atomicAdd(&(bar)[XB_TMO], 1u); break; } } } } while (0)
DEVI void xcd_barrier_complete(unsigned* bar, unsigned x, unsigned& nloc, unsigned& nx) {
  const unsigned G = gridDim.x * gridDim.y * gridDim.z;
  unsigned sum, cnt, mine, sp = 0u;
  for (;;) {
    sum = 0u; cnt = 0u; mine = 0u;
#pragma unroll
    for (unsigned j = 0; j < 16; ++j) { const unsigned c = xb_ld(&bar[XB_XCNT(j)]); sum += c; cnt += (c > 0u) ? 1u : 0u; mine = (j == x) ? c : mine; }
    if (sum == G) break;
    __builtin_amdgcn_s_sleep(1);
    if ((++sp & 255u) == 0u) { if (xb_ld(&bar[XB_TMO])) break; if (sp > XB_SPIN_CAP) { atomicAdd(&bar[XB_TMO], 1u); break; } }
  }
  nloc = mine > 0u ? mine : 1u; nx = cnt > 0u ? cnt : 1u;
}
DEVI void xcd_barrier(char* ws, char* lds, int wv) {
  asm volatile("s_waitcnt vmcnt(0)" ::: "memory");
  __syncthreads();
  if (is_t0(wv)) {
    unsigned* bar = reinterpret_cast<unsigned*>(ws + O_XBAR);
    volatile LAS unsigned* st = (volatile LAS unsigned*)(unsigned)((unsigned)(uintptr_t)lds + LDS_BYTES);
    const unsigned x = xb_xcc_id();
    __builtin_amdgcn_s_waitcnt(0);
    unsigned nloc = st[0], nx = st[1];
    if (nloc == 0u) { xcd_barrier_complete(bar, x, nloc, nx); st[0] = nloc; st[1] = nx; }
    const unsigned old = xb_add(&bar[XB_XSUB(x)], 1u);
    const unsigned gen = old / nloc;
    if (old + 1u == (gen + 1u) * nloc) {
      __builtin_amdgcn_fence(__ATOMIC_RELEASE, "agent");
      asm volatile("s_waitcnt vmcnt(0)" ::: "memory");
      const unsigned og = xb_add(&bar[XB_TOP], 1u);
      const unsigned tg = og / nx;
      if (og + 1u == (tg + 1u) * nx) xb_add(&bar[XB_TOPGEN], 1u);
      else XB_SPIN(xb_ld(&bar[XB_TOPGEN]) == tg, bar);
      __builtin_amdgcn_fence(__ATOMIC_ACQUIRE, "agent");
      xb_add(&bar[XB_XGEN(x)], 1u);
      asm volatile("s_waitcnt vmcnt(0)" ::: "memory");
    } else {
      XB_SPIN(xb_ld(&bar[XB_XGEN(x)]) == gen, bar);
      __builtin_amdgcn_fence(__ATOMIC_ACQUIRE, "agent");
      asm volatile("s_waitcnt vmcnt(0)" ::: "memory");
    }
  }
  __syncthreads();
}

DEVI void gsync(unsigned* ctr, unsigned gen, int wv) {
  asm volatile("s_waitcnt vmcnt(0)" ::: "memory");
  __syncthreads();
  if (is_t0(wv)) {
    __builtin_amdgcn_fence(__ATOMIC_RELEASE, "agent");
    asm volatile("s_waitcnt vmcnt(0)" ::: "memory");
    __hip_atomic_fetch_add(ctr, 1u, __ATOMIC_RELAXED, __HIP_MEMORY_SCOPE_AGENT);
    const unsigned target = gen * gridDim.x;
    while (__hip_atomic_load(ctr, __ATOMIC_RELAXED, __HIP_MEMORY_SCOPE_AGENT) < target) __builtin_amdgcn_s_sleep(1);
    __builtin_amdgcn_fence(__ATOMIC_ACQUIRE, "agent");
    asm volatile("s_waitcnt vmcnt(0)" ::: "memory");
  }
  __syncthreads();
}

#ifndef PH_MASK
#define PH_MASK 0xff
#endif
#ifndef REP_MASK
#define REP_MASK 0
#endif
__global__ void __launch_bounds__(NTHR) fwd_megakernel(Params P) {
  extern __shared__ __attribute__((aligned(16))) char lds[];
  cg::grid_group grid = cg::this_grid();
  const int wv = __builtin_amdgcn_readfirstlane((int)(threadIdx.x >> 6));
  {
    volatile LAS unsigned* xst = (volatile LAS unsigned*)(unsigned)((unsigned)(uintptr_t)lds + LDS_BYTES);
    if (threadIdx.x == 0) { xst[0] = 0u; xst[1] = 0u; (void)xb_add(reinterpret_cast<unsigned*>(P.ws + O_XBAR) + XB_XCNT(xb_xcc_id()), 1u); }
    __syncthreads();
  }
  if constexpr (PH_MASK & 1) phase_prep(wv, P, lds);
  grid.sync();
#pragma nounroll
  for (int layer = 0; layer < 2; ++layer) {
    const bool last = layer == 1;
    unsigned* bar = reinterpret_cast<unsigned*>(ows(P.ws + O_BAR));
    const unsigned g0 = layer * 6;
    if constexpr (PH_MASK & 2) phase_hnorm(wv, P, layer);
    if constexpr (PH_MASK & 1) { if (layer == 0) phase_wprep(wv, P); }
    xcd_barrier(P.ws, lds, wv);
    if constexpr (PH_MASK & 4) phase_gemm_in(wv, P, layer, last, lds);
    xcd_barrier(P.ws, lds, wv);
    if constexpr (PH_MASK & 8) phase_rows(wv, P, layer, last, lds);
    if constexpr (REP_MASK & 8) { __syncthreads(); phase_rows(wv, P, layer, last, lds); }
    xcd_barrier(P.ws, lds, wv);
    if constexpr (PH_MASK & 16) phase_gemm_mid(wv, P, layer, last, lds);
    if constexpr (REP_MASK & 16) { __syncthreads(); phase_gemm_mid(wv, P, layer, last, lds); }
    xcd_barrier(P.ws, lds, wv);
    unsigned badmask = 0u;
    if constexpr (PH_MASK & 32) badmask = phase_attn<true>(wv, P, last, lds, 0u);
    if (badmask && is_t0(wv)) __hip_atomic_fetch_add(bar + 16 + layer, 1u, __ATOMIC_RELAXED, __HIP_MEMORY_SCOPE_AGENT);
    xcd_barrier(P.ws, lds, wv);
    if (__hip_atomic_load(bar + 16 + layer, __ATOMIC_RELAXED, __HIP_MEMORY_SCOPE_AGENT) != 0u) {
      if constexpr (PH_MASK & 32) phase_attn<false>(wv, P, last, lds, badmask);
      xcd_barrier(P.ws, lds, wv);
    }
    if constexpr (PH_MASK & 64) phase_gemm_out(wv, P, layer, last, lds);
    if constexpr (REP_MASK & 64) { if (!last) { __syncthreads(); phase_gemm_out(wv, P, layer, last, lds); } }
    xcd_barrier(P.ws, lds, wv);
  }
  if constexpr (PH_MASK & 128) phase_final(wv, P);
}

extern "C" void kernel_launch(void* const* d_in, const int* in_sizes, int n_in, void* d_out, int out_size, void* d_ws, size_t ws_size, hipStream_t stream) {
  static int grid_blocks = 0;
  if (!grid_blocks) {
    int dev = 0, cus = 0, per_cu = 0;
    hipGetDevice(&dev);
    hipDeviceGetAttribute(&cus, hipDeviceAttributeMultiprocessorCount, dev);
    hipFuncSetAttribute((const void*)fwd_megakernel, hipFuncAttributeMaxDynamicSharedMemorySize, LDS_BYTES + 16);
    hipOccupancyMaxActiveBlocksPerMultiprocessor(&per_cu, fwd_megakernel, NTHR, LDS_BYTES + 16);
    if (per_cu < 1) { fprintf(stderr, "kernel_launch: occupancy query returned %d\n", per_cu); per_cu = 1; }
    grid_blocks = cus;
    if (ws_size < O_END) fprintf(stderr, "kernel_launch: workspace too small: %zu < %zu\n", ws_size, (size_t)O_END);
  }
  Params p{};
  const float** f = reinterpret_cast<const float**>(&p);
  for (int i = 0; i < 22; ++i) f[i] = static_cast<const float*>(d_in[i]);
  p.out = static_cast<float*>(d_out);
  p.ws = static_cast<char*>(d_ws);
  hipMemsetAsync(p.ws + O_BAR, 0, 256 + 3456 * 4, stream);
  void* args[] = {&p};
  hipError_t e = hipLaunchCooperativeKernel((const void*)fwd_megakernel, dim3(grid_blocks), dim3(NTHR), args, LDS_BYTES + 16, stream);
  if (e != hipSuccess) fprintf(stderr, "cooperative launch failed: %s (grid %d)\n", hipGetErrorString(e), grid_blocks);
}
```

```cpp
#include <hip/hip_runtime.h>
#include <hip/hip_cooperative_groups.h>
#include <cstdio>
#include <cstdint>
namespace cg = cooperative_groups;

#define DEVI __device__ __forceinline__
typedef unsigned short bfu;
typedef __attribute__((ext_vector_type(8))) short bf16x8;
typedef __attribute__((ext_vector_type(4))) short s16x4;
typedef __attribute__((ext_vector_type(16))) float f32x16;
typedef __attribute__((ext_vector_type(4))) float f32x4;
typedef __attribute__((ext_vector_type(4))) unsigned u32x4;
typedef __attribute__((ext_vector_type(2))) unsigned u32x2;

constexpr int NB = 8, SEQ = 4096, DM = 1024, CTX = 256, TK = SEQ + CTX;
constexpr int ML = NB * SEQ, MC = NB * CTX, MT = ML + MC;
constexpr int INC = 2592, INP = 2816;
constexpr int NTHR = 512;
constexpr float EPS = 1e-6f;
constexpr float LOG2E = 1.4426950408889634f;
constexpr float QS_M = 0.10206207261596575f * LOG2E;
constexpr float QS_G = 0.125f * LOG2E;
constexpr int PC_MLAQ = 0, PC_KV = 256, PC_KR = 384, PC_GK = 416, PC_GV = 544, PC_GQ = 672, PC_CONV = 1056, PC_GATE = 1568;

constexpr size_t al256(size_t x) { return (x + 255) / 256 * 256; }
constexpr size_t SZ_WIN = (size_t)INP * 1024 * 2, SZ_WUQ = (size_t)640 * 256 * 2, SZ_WUKV = (size_t)768 * 128 * 2, SZ_WPW = (size_t)256 * 256 * 2,
                 SZ_WOUT = (size_t)1024 * 1024 * 2;
constexpr size_t O_WIN = 0;
constexpr size_t O_WUQ = O_WIN + 2 * SZ_WIN;
constexpr size_t O_WUKV = O_WUQ + 2 * SZ_WUQ;
constexpr size_t O_WPW = O_WUKV + 2 * SZ_WUKV;
constexpr size_t O_WOUT = O_WPW + 2 * SZ_WPW;
constexpr size_t O_MOD = O_WOUT + 2 * SZ_WOUT;
constexpr size_t O_ROPE = O_MOD + al256((size_t)2 * 9 * 3072 * 4);
constexpr size_t O_STATS = O_ROPE + al256((size_t)3072 * 4);
constexpr size_t O_CTX1 = O_STATS + al256((size_t)MT * 2 * 4);
constexpr size_t O_H = O_CTX1 + (size_t)MC * 1024 * 4;
constexpr size_t O_P = O_H + (size_t)MT * 1024 * 2;
constexpr size_t O_QM = O_P + (size_t)MT * INC * 2;
constexpr size_t O_KM = O_QM + (size_t)NB * 6 * TK * 96 * 2;
constexpr size_t O_VM = O_KM + (size_t)NB * 6 * TK * 96 * 2;
constexpr size_t O_QG = O_VM + (size_t)NB * 6 * TK * 64 * 2;
constexpr size_t O_KG = O_QG + (size_t)NB * 6 * TK * 64 * 2;
constexpr size_t O_VG = O_KG + (size_t)NB * 2 * TK * 64 * 2;
constexpr size_t O_Z = O_VG + (size_t)NB * 2 * TK * 64 * 2;
constexpr size_t O_BAR = O_Z + (size_t)MT * 256 * 2;
constexpr size_t O_D = O_QM;
static_assert((size_t)MT * 1024 * 2 <= O_VM - O_QM, "d does not fit");
constexpr size_t O_XBAR = O_BAR + 256;
constexpr size_t O_END = O_XBAR + 3456 * 4;

struct Params {
  const float *x, *c, *ctx, *c_ctx, *norm_w, *w_mod, *b_mod, *w_in, *mla_q_norm, *mla_w_uq, *mla_kv_norm, *mla_w_ukv, *gqa_q_norm, *gqa_k_norm,
      *conv_dw_w, *conv_dw_b, *conv_ln_w, *conv_ln_b, *conv_pw_w, *conv_pw_b, *w_out, *final_norm_w;
  float* out;
  char* ws;
};

DEVI unsigned short f2bf(float f) { unsigned u = __float_as_uint(f); u += 0x7fffu + ((u >> 16) & 1u); return (unsigned short)(u >> 16); }
DEVI float bf2f(unsigned short h) { return __uint_as_float(((unsigned)h) << 16); }
DEVI unsigned pk2(float lo, float hi) { return (unsigned)f2bf(lo) | ((unsigned)f2bf(hi) << 16); }
DEVI unsigned cvtpk(float lo, float hi) { unsigned r; asm volatile("v_cvt_pk_bf16_f32 %0, %1, %2" : "=v"(r) : "v"(lo), "v"(hi)); return r; }
DEVI float bflo(unsigned w) { return __uint_as_float(w << 16); }
DEVI float bfhi(unsigned w) { return __uint_as_float(w & 0xffff0000u); }
DEVI int otid(int wv) { int t = (wv << 6) | (int)__builtin_amdgcn_mbcnt_hi(~0u, __builtin_amdgcn_mbcnt_lo(~0u, 0u)); asm volatile("" : "+v"(t)); return t; }
DEVI int obid() { int t = blockIdx.x; asm volatile("" : "+s"(t)); return t; }
DEVI char* ows(const char* p) { char* q = const_cast<char*>(p); asm volatile("" : "+s"(q)); return q; }
template <int X> DEVI float swz_xor(float v) { return __int_as_float(__builtin_amdgcn_ds_swizzle(__float_as_int(v), (X << 10) | 0x1f)); }
DEVI float wsum(float v) {
  v += swz_xor<1>(v); v += swz_xor<2>(v); v += swz_xor<4>(v); v += swz_xor<8>(v); v += swz_xor<16>(v);
  auto rr = __builtin_amdgcn_permlane32_swap(__float_as_uint(v), __float_as_uint(v), false, false);
  return __uint_as_float(rr[0]) + __uint_as_float(rr[1]);
}
DEVI float siluf(float v) { return v * __builtin_amdgcn_rcpf(1.f + __expf(-v)); }
DEVI int crow(int r, int hi) { return (r & 3) + 8 * (r >> 2) + 4 * hi; }
DEVI f32x16 mfma32(bf16x8 a, bf16x8 b, f32x16 c) { return __builtin_amdgcn_mfma_f32_32x32x16_bf16(a, b, c, 0, 0, 0); }

DEVI void rowinfo(int row, int& b, int& t, int& v) {
  if (row < ML) { b = row >> 12; t = row & 4095; v = b; }
  else { int rc = row - ML; b = rc >> 8; t = SEQ + (rc & 255); v = 8; }
}

DEVI void prep_transpose(const float* __restrict__ src, bfu* __restrict__ dst, int K, int N, int Npad, const float* __restrict__ gk, int gtid, int gthreads) {
  const int items = Npad * (K / 8);
  for (int i = gtid; i < items; i += gthreads) {
    const int n = i % Npad, k8 = i / Npad;
    u32x4 w = {0u, 0u, 0u, 0u};
    if (n < N) {
      float v[8];
#pragma unroll
      for (int j = 0; j < 8; ++j) { float s = src[(size_t)(k8 * 8 + j) * N + n]; if (gk) s *= gk[k8 * 8 + j]; v[j] = s; }
      w[0] = pk2(v[0], v[1]); w[1] = pk2(v[2], v[3]); w[2] = pk2(v[4], v[5]); w[3] = pk2(v[6], v[7]);
    }
    *reinterpret_cast<u32x4*>(dst + (size_t)n * K + k8 * 8) = w;
  }
}

DEVI void sincos_d(double a, float& c, float& s) {
  const double TWO_PI = 6.283185307179586476925286766559;
  double k = rint(a / TWO_PI);
  double r = a - k * TWO_PI;
  double r2 = r * r, ts = r, ss = r, tc = 1.0, cc = 1.0;
#pragma unroll
  for (int n = 1; n <= 14; ++n) {
    ts *= -r2 / (double)((2 * n) * (2 * n + 1)); ss += ts;
    tc *= -r2 / (double)((2 * n - 1) * (2 * n)); cc += tc;
  }
  c = (float)cc; s = (float)ss;
}

DEVI void phase_prep(int wv, const Params& P, char* lds) {
  const int tid = otid(wv), wid = tid >> 6, lane = tid & 63;
  const int gtid = blockIdx.x * NTHR + tid, gthreads = gridDim.x * NTHR;
  float* sc = reinterpret_cast<float*>(lds);
  float* part = sc + 9 * 1024;
  float* mod = reinterpret_cast<float*>(P.ws + O_MOD);
  bool staged = false;
  for (int it = blockIdx.x; it < 96; it += gridDim.x) {
    if (!staged) {
      for (int idx = tid; idx < 9 * 1024; idx += NTHR) {
        int v = idx >> 10, k = idx & 1023;
        float cv = (v < 8) ? P.c[v * 1024 + k] : P.c_ctx[k];
        sc[idx] = siluf(cv);
      }
      staged = true;
    }
    __syncthreads();
    const int l = it / 48, j0 = (it % 48) * 64;
    const float* wm = P.w_mod + (size_t)l * 1024 * 3072 + j0 + lane;
    float acc[9];
#pragma unroll
    for (int v = 0; v < 9; ++v) acc[v] = 0.f;
    for (int k = wid * 128; k < wid * 128 + 128; k += 16) {
      float wv[16];
#pragma unroll
      for (int u = 0; u < 16; ++u) wv[u] = wm[(size_t)(k + u) * 3072];
#pragma unroll
      for (int v = 0; v < 9; ++v) {
        const float* s_ = sc + v * 1024 + k;
        float a_ = 0.f;
#pragma unroll
        for (int u = 0; u < 16; ++u) a_ += s_[u] * wv[u];
        acc[v] += a_;
      }
    }
#pragma unroll
    for (int v = 0; v < 9; ++v) part[(wid * 9 + v) * 64 + lane] = acc[v];
    __syncthreads();
    for (int o = tid; o < 9 * 64; o += NTHR) {
      int v = o >> 6, jl = o & 63;
      float s = P.b_mod[l * 3072 + j0 + jl];
#pragma unroll
      for (int w = 0; w < 8; ++w) s += part[(w * 9 + v) * 64 + jl];
      mod[((size_t)l * 9 + v) * 3072 + j0 + jl] = s;
    }
    __syncthreads();
  }
  if (gtid < 1536) {
    float* rt = reinterpret_cast<float*>(P.ws + O_ROPE);
    int pos, i, half; float* cdst; float* sdst;
    if (gtid < 512) { pos = gtid >> 3; i = gtid & 7; half = 8; cdst = rt + gtid; sdst = rt + 512 + gtid; }
    else { int g = gtid - 512; pos = g >> 4; i = g & 15; half = 16; cdst = rt + 1024 + g; sdst = rt + 2048 + g; }
    float freq = exp2f(-(float)i / (float)half * 13.287712379549449f);
    float ang = (float)pos * freq;
    float c, s; sincos_d((double)ang, c, s);
    *cdst = c; *sdst = s;
  }
}

DEVI void phase_wprep(int wv, const Params& P) {
  const int tid = otid(wv);
  const int gtid = blockIdx.x * NTHR + tid, gthreads = gridDim.x * NTHR;
  for (int l = 0; l < 2; ++l) {
    prep_transpose(P.w_in + (size_t)l * 1024 * INC, reinterpret_cast<bfu*>(P.ws + O_WIN + l * SZ_WIN), 1024, INC, INP, nullptr, gtid, gthreads);
    prep_transpose(P.mla_w_uq + (size_t)l * 256 * 576, reinterpret_cast<bfu*>(P.ws + O_WUQ + l * SZ_WUQ), 256, 576, 640, P.mla_q_norm + l * 256, gtid, gthreads);
    prep_transpose(P.mla_w_ukv + (size_t)l * 128 * 768, reinterpret_cast<bfu*>(P.ws + O_WUKV + l * SZ_WUKV), 128, 768, 768, P.mla_kv_norm + l * 128, gtid, gthreads);
    prep_transpose(P.conv_pw_w + (size_t)l * 256 * 256, reinterpret_cast<bfu*>(P.ws + O_WPW + l * SZ_WPW), 256, 256, 256, nullptr, gtid, gthreads);
    prep_transpose(P.w_out + (size_t)l * 1024 * 1024, reinterpret_cast<bfu*>(P.ws + O_WOUT + l * SZ_WOUT), 1024, 1024, 1024, nullptr, gtid, gthreads);
  }
}

DEVI void hnorm_rows(const float* __restrict__ src, float* __restrict__ xdst, bfu* __restrict__ hdst, const bfu* __restrict__ dsrc,
                     int i0, int istep, int n, const float* __restrict__ modv, const float* __restrict__ g0v, const float* __restrict__ nwp,
                     bool apply_res, int lane) {
  f32x4 A[4], S0[4], G0[4];
#pragma unroll
  for (int i = 0; i < 4; ++i) {
    const int col = (i * 64 + lane) * 4;
    const f32x4 g = *reinterpret_cast<const f32x4*>(nwp + col), s1 = *reinterpret_cast<const f32x4*>(modv + 1024 + col);
    S0[i] = *reinterpret_cast<const f32x4*>(modv + col);
    A[i] = f32x4{g[0] * (1.f + s1[0]), g[1] * (1.f + s1[1]), g[2] * (1.f + s1[2]), g[3] * (1.f + s1[3])};
    G0[i] = apply_res ? *reinterpret_cast<const f32x4*>(g0v + col) : f32x4{0.f, 0.f, 0.f, 0.f};
  }
  f32x4 XA[2][4], XB[2][4]; u32x2 DA[2][4], DB[2][4];
#define LOADSET(X, D, IB) do { _Pragma("unroll") for (int q = 0; q < 2; ++q) { const int idx = (IB) + q * istep; if (idx < n) { \
      _Pragma("unroll") for (int i = 0; i < 4; ++i) X[q][i] = *reinterpret_cast<const f32x4*>(src + (size_t)idx * 1024 + (i * 64 + lane) * 4); \
      if (apply_res) { _Pragma("unroll") for (int i = 0; i < 4; ++i) D[q][i] = *reinterpret_cast<const u32x2*>(dsrc + (size_t)idx * 1024 + (i * 64 + lane) * 4); } } } } while (0)
#define PROCSET(X, D, IB) do { _Pragma("unroll") for (int q = 0; q < 2; ++q) { const int idx = (IB) + q * istep; if (idx < n) { \
      if (apply_res) { _Pragma("unroll") for (int i = 0; i < 4; ++i) { \
          X[q][i][0] += G0[i][0] * bflo(D[q][i][0]); X[q][i][1] += G0[i][1] * bfhi(D[q][i][0]); \
          X[q][i][2] += G0[i][2] * bflo(D[q][i][1]); X[q][i][3] += G0[i][3] * bfhi(D[q][i][1]); \
          *reinterpret_cast<f32x4*>(xdst + (size_t)idx * 1024 + (i * 64 + lane) * 4) = X[q][i]; } } \
      float ss = 0.f; \
      _Pragma("unroll") for (int i = 0; i < 4; ++i) ss += X[q][i][0] * X[q][i][0] + X[q][i][1] * X[q][i][1] + X[q][i][2] * X[q][i][2] + X[q][i][3] * X[q][i][3]; \
      ss = wsum(ss); \
      const float r = rsqrtf(ss * (1.f / 1024.f) + EPS); \
      _Pragma("unroll") for (int i = 0; i < 4; ++i) { \
        const float o0 = X[q][i][0] * r * A[i][0] + S0[i][0], o1 = X[q][i][1] * r * A[i][1] + S0[i][1]; \
        const float o2 = X[q][i][2] * r * A[i][2] + S0[i][2], o3 = X[q][i][3] * r * A[i][3] + S0[i][3]; \
        u32x2 w = {pk2(o0, o1), pk2(o2, o3)}; \
        *reinterpret_cast<u32x2*>(hdst + (size_t)idx * 1024 + (i * 64 + lane) * 4) = w; } } } } while (0)
  int ib = i0;
  LOADSET(XA, DA, ib);
  while (ib < n) {
    LOADSET(XB, DB, ib + 2 * istep);
    PROCSET(XA, DA, ib);
    ib += 2 * istep; if (ib >= n) break;
    LOADSET(XA, DA, ib + 2 * istep);
    PROCSET(XB, DB, ib);
    ib += 2 * istep;
  }
#undef LOADSET
#undef PROCSET
}

DEVI void phase_hnorm(int wv, const Params& P, int layer) {
  const int tid = otid(wv), wid = tid >> 6, lane = tid & 63;
  const int gw = blockIdx.x * (NTHR / 64) + wid, nw = gridDim.x * (NTHR / 64);
  const float* mod = reinterpret_cast<const float*>(P.ws + O_MOD) + (size_t)layer * 9 * 3072;
  const float* mod0 = reinterpret_cast<const float*>(P.ws + O_MOD);
  const float* nwp = P.norm_w + layer * 1024;
  bfu* hb = reinterpret_cast<bfu*>(P.ws + O_H);
  const bfu* dbuf = reinterpret_cast<const bfu*>(P.ws + O_D);
  const bool res = layer == 1;
  {
    const int b = gw & 7;
    const size_t ro = (size_t)b * SEQ * 1024;
    hnorm_rows(P.x + ro, P.out + ro, hb + ro, dbuf + ro, gw >> 3, nw >> 3, SEQ, mod + (size_t)b * 3072, mod0 + (size_t)b * 3072 + 2048, nwp, res, lane);
  }
  {
    const size_t ro = (size_t)ML * 1024;
    hnorm_rows(P.ctx, reinterpret_cast<float*>(P.ws + O_CTX1), hb + ro, dbuf + ro, gw, nw, MC, mod + (size_t)8 * 3072, mod0 + (size_t)8 * 3072 + 2048, nwp, res, lane);
  }
}

constexpr int GROW = 144;
constexpr int G_A_BYTES = 256 * GROW;
constexpr int g_stage(int wn) { return G_A_BYTES + 64 * wn * GROW; }
constexpr int LDS_BYTES = 2 * g_stage(4);
enum { EPI_P = 0, EPI_Q = 1, EPI_KV = 2, EPI_CONV = 3, EPI_OUT = 4 };

struct NextTile { const bfu* A; const bfu* Bt; int lda, ldb, m0, n0; bool valid; };
template <int EPI, int WN>
DEVI void gemm_tile(const bfu* __restrict__ A, int lda, const bfu* __restrict__ Bt, int ldb, int K, int m0, int n0, char* lds, const Params& P, int layer, int tid,
                    u32x4 (&ra)[4], u32x4 (&rb)[WN], bool have_pref, const NextTile& nx) {
  const int wid = tid >> 6, lane = tid & 63, r32 = lane & 31, hi = lane >> 5;
  constexpr int MI = WN, G_STAGE = g_stage(WN);
  const int wm = wid / WN, wn = wid % WN;
  const int srow = tid >> 3, sch = tid & 7;
  const bfu* Ag = A + (size_t)(m0 + srow) * lda + sch * 8;
  const bfu* Bg = Bt + (size_t)(n0 + srow) * ldb + sch * 8;
  f32x16 acc[MI][2];
#pragma unroll
  for (int i = 0; i < MI; ++i)
#pragma unroll
    for (int j = 0; j < 2; ++j)
#pragma unroll
      for (int r = 0; r < 16; ++r) acc[i][j][r] = 0.f;
  const int nk = K / 64;
#define GLOAD(k0) do { _Pragma("unroll") for (int i = 0; i < 4; ++i) ra[i] = *reinterpret_cast<const u32x4*>(Ag + (size_t)(64 * i) * lda + (k0)); \
    _Pragma("unroll") for (int i = 0; i < WN; ++i) rb[i] = *reinterpret_cast<const u32x4*>(Bg + (size_t)(64 * i) * ldb + (k0)); } while (0)
#define LWRITE(buf) do { char* a_ = lds + (buf) * G_STAGE; _Pragma("unroll") for (int i = 0; i < 4; ++i) *reinterpret_cast<u32x4*>(a_ + (srow + 64 * i) * GROW + sch * 16) = ra[i]; \
    char* b_ = a_ + G_A_BYTES; _Pragma("unroll") for (int i = 0; i < WN; ++i) *reinterpret_cast<u32x4*>(b_ + (srow + 64 * i) * GROW + sch * 16) = rb[i]; } while (0)
#define LDFR(kk, B0, B1, AF) do { B0 = *reinterpret_cast<const bf16x8*>(fb + (kk) * 32); B1 = *reinterpret_cast<const bf16x8*>(fb + 32 * GROW + (kk) * 32); \
    _Pragma("unroll") for (int mi = 0; mi < MI; ++mi) AF[mi] = *reinterpret_cast<const bf16x8*>(fa + mi * 32 * GROW + (kk) * 32); } while (0)
#define MM(B0, B1, AF) do { _Pragma("unroll") for (int mi = 0; mi < MI; ++mi) { acc[mi][0] = mfma32(AF[mi], B0, acc[mi][0]); acc[mi][1] = mfma32(AF[mi], B1, acc[mi][1]); } } while (0)
  bf16x8 b0x, b1x, afx[MI], b0y, b1y, afy[MI];
#define PIECE_A(i) do { if (kt + 1 < nk) *reinterpret_cast<u32x4*>(wbase + (srow + 64 * (i)) * GROW + sch * 16) = ra[i]; \
    if (kt + 2 < nk) ra[i] = *reinterpret_cast<const u32x4*>(Ag + (size_t)(64 * (i)) * lda + (kt + 2) * 64); } while (0)
#define PIECE_B(i) do { if (kt + 1 < nk) *reinterpret_cast<u32x4*>(wbase + G_A_BYTES + (srow + 64 * (i)) * GROW + sch * 16) = rb[i]; \
    if (kt + 2 < nk) rb[i] = *reinterpret_cast<const u32x4*>(Bg + (size_t)(64 * (i)) * ldb + (kt + 2) * 64); } while (0)
#define SB_() __builtin_amdgcn_sched_barrier(0)
  if (have_pref) {
#pragma unroll
    for (int i = 0; i < WN; ++i) rb[i] = *reinterpret_cast<const u32x4*>(Bg + (size_t)(64 * i) * ldb);
  } else GLOAD(0);
  LWRITE(0);
  if (1 < nk) GLOAD(64);
  __syncthreads();
  for (int kt = 0; kt < nk; ++kt) {
    const char* fa = lds + (kt & 1) * G_STAGE + (wm * (MI * 32) + r32) * GROW + hi * 16;
    const char* fb = lds + (kt & 1) * G_STAGE + G_A_BYTES + (wn * 64 + r32) * GROW + hi * 16;
    char* wbase = lds + ((kt + 1) & 1) * G_STAGE;
    LDFR(0, b0x, b1x, afx);
    LDFR(1, b0y, b1y, afy);
    SB_(); MM(b0x, b1x, afx); SB_();
    PIECE_A(0); PIECE_A(1);
    LDFR(2, b0x, b1x, afx);
    SB_(); MM(b0y, b1y, afy); SB_();
    PIECE_A(2); PIECE_A(3);
    LDFR(3, b0y, b1y, afy);
    SB_(); MM(b0x, b1x, afx); SB_();
    PIECE_B(0); if constexpr (WN == 4) PIECE_B(1);
    SB_(); MM(b0y, b1y, afy); SB_();
    if constexpr (WN == 4) { PIECE_B(2); PIECE_B(3); } else { PIECE_B(1); }
    __syncthreads();
  }
  if (nx.valid) {
    const bfu* An_ = nx.A + (size_t)(nx.m0 + srow) * nx.lda + sch * 8;
#pragma unroll
    for (int i = 0; i < 4; ++i) ra[i] = *reinterpret_cast<const u32x4*>(An_ + (size_t)(64 * i) * nx.lda);
  }
#undef PIECE_A
#undef PIECE_B
#undef SB_
#undef GLOAD
#undef LWRITE
#undef LDFR
#undef MM
  const bool latent = m0 < ML;
  const int tb_b = latent ? (m0 >> 12) : ((m0 - ML) >> 8), tb_t = latent ? (m0 & 4095) : SEQ;
  bfu* pbuf = reinterpret_cast<bfu*>(P.ws + O_P);
  const float* stats = reinterpret_cast<const float*>(P.ws + O_STATS);
  {
    char* reg = lds + G_STAGE + wid * (32 * GROW);
    const float* rt = reinterpret_cast<const float*>(P.ws + O_ROPE);
    const int cw0 = n0 + wn * 64;
    float cbias[2] = {0.f, 0.f};
    if constexpr (EPI == EPI_CONV) { cbias[0] = P.conv_pw_b[layer * 256 + cw0 + r32]; cbias[1] = P.conv_pw_b[layer * 256 + cw0 + 32 + r32]; }
#pragma unroll
    for (int mi = 0; mi < MI; ++mi) {
      float st[16];
      if constexpr (EPI == EPI_Q || EPI == EPI_KV) {
#pragma unroll
        for (int r = 0; r < 16; ++r) st[r] = stats[(m0 + wm * (MI * 32) + mi * 32 + crow(r, hi)) * 2 + (EPI == EPI_KV ? 1 : 0)];
      }
#pragma unroll
      for (int ni = 0; ni < 2; ++ni) {
        const int nb = cw0 + ni * 32;
        bool rope = false;
        if constexpr (EPI == EPI_Q) rope = latent && ((nb % 96) / 32 == 2) && (nb < 576);
        float cs[16], sn[16];
        if constexpr (EPI == EPI_Q) {
          if (rope) {
            const int sec = r32 >> 4, fi = r32 & 7;
#pragma unroll
            for (int r = 0; r < 16; ++r) {
              const int t = tb_t + wm * (MI * 32) + mi * 32 + crow(r, hi); const int pos = sec ? (t & 63) : (t >> 6);
              cs[r] = rt[pos * 8 + fi]; sn[r] = rt[512 + pos * 8 + fi];
            }
          }
        }
#pragma unroll
        for (int r = 0; r < 16; ++r) {
          float v = acc[mi][ni][r];
          if constexpr (EPI == EPI_Q || EPI == EPI_KV) v *= st[r];
          if constexpr (EPI == EPI_CONV) v += cbias[ni];
          if constexpr (EPI == EPI_Q) {
            if (rope) { const float pn = swz_xor<8>(v); v = !(r32 & 8) ? (v * cs[r] - pn * sn[r]) : (pn * sn[r] + v * cs[r]); }
            v *= QS_M;
          }
          *reinterpret_cast<bfu*>(reg + crow(r, hi) * GROW + (ni * 32 + r32) * 2) = f2bf(v);
        }
      }
#pragma unroll
      for (int i = 0; i < 4; ++i) {
        const int q_ = lane + 64 * i, rr = q_ >> 3, ch = q_ & 7;
        const u32x4 w = *reinterpret_cast<const u32x4*>(reg + rr * GROW + ch * 16);
        const int lr = wm * (MI * 32) + mi * 32 + rr, colc = cw0 + ch * 8;
        if constexpr (EPI == EPI_P) {
          if (colc < INC) *reinterpret_cast<u32x4*>(pbuf + (size_t)(m0 + lr) * INC + colc) = w;
        } else if constexpr (EPI == EPI_Q) {
          if (colc < 576) { const int h = colc / 96, d = colc % 96;
            *reinterpret_cast<u32x4*>(reinterpret_cast<bfu*>(P.ws + O_QM) + ((size_t)(tb_b * 6 + h) * TK + tb_t + lr) * 96 + d) = w; }
        } else if constexpr (EPI == EPI_OUT) {
          *reinterpret_cast<u32x4*>(reinterpret_cast<bfu*>(P.ws + O_D) + (size_t)(m0 + lr) * 1024 + colc) = w;
        } else if constexpr (EPI == EPI_CONV) {
          const u32x4 gw = *reinterpret_cast<const u32x4*>(pbuf + (size_t)(m0 + lr) * INC + PC_GATE + 768 + colc);
          u32x4 o;
#pragma unroll
          for (int j = 0; j < 4; ++j) o[j] = pk2(bflo(w[j]) * siluf(bflo(gw[j])), bfhi(w[j]) * siluf(bfhi(gw[j])));
          *reinterpret_cast<u32x4*>(reinterpret_cast<bfu*>(P.ws + O_H) + (size_t)(m0 + lr) * 1024 + 768 + colc) = o;
        } else {
          const int h = colc >> 7, e = colc & 127;
          bfu* dst = (e < 64) ? reinterpret_cast<bfu*>(P.ws + O_KM) + ((size_t)(tb_b * 6 + h) * TK + tb_t + lr) * 96 + e
                              : reinterpret_cast<bfu*>(P.ws + O_VM) + ((size_t)(tb_b * 6 + h) * TK + tb_t + lr) * 64 + (e - 64);
          *reinterpret_cast<u32x4*>(dst) = w;
        }
      }
    }
  }
}

DEVI void blk_group(int& grp, int& loc, int& per, int& ngrp) {
  const int nb = gridDim.x;
  if ((nb & 7) == 0) { grp = blockIdx.x & 7; loc = blockIdx.x >> 3; per = nb >> 3; ngrp = 8; }
  else { grp = 0; loc = blockIdx.x; per = nb; ngrp = 1; }
}

DEVI void phase_gemm_in(int wv, const Params& P, int layer, bool last, char* lds) {
  const int tid = otid(wv);
  const bfu* A = reinterpret_cast<const bfu*>(P.ws + O_H);
  const bfu* Bt = reinterpret_cast<const bfu*>(P.ws + O_WIN + layer * SZ_WIN);
  constexpr int PANELS = MT / 256, NT = INP / 256;
  int grp, loc, per, ngrp; blk_group(grp, loc, per, ngrp);
  const int PG = PANELS / ngrp, g0 = grp * PG;
  const NextTile none{nullptr, nullptr, 0, 0, 0, 0, false};
  for (int tl = loc; tl < PG * NT; tl += per) {
    const int pm = g0 + tl / NT, pn = tl % NT;
    if (last && pm * 256 >= ML && (pn < 1 || pn > 2)) continue;
    u32x4 ra[4], rb[4];
    gemm_tile<EPI_P, 4>(A, 1024, Bt, 1024, 1024, pm * 256, pn * 256, lds, P, layer, tid, ra, rb, false, none);
  }
}

DEVI void phase_rows(int wv, const Params& P, int layer, bool last, char* lds) {
  const int tid = otid(wv), wid = tid >> 6, lane = tid & 63;
  const int gw = blockIdx.x * (NTHR / 64) + wid, nw = gridDim.x * (NTHR / 64);
  const bfu* pbuf = reinterpret_cast<const bfu*>(P.ws + O_P);
  float* stats = reinterpret_cast<float*>(P.ws + O_STATS);
  const float* rt = reinterpret_cast<const float*>(P.ws + O_ROPE);
  bfu* Km = reinterpret_cast<bfu*>(P.ws + O_KM);
  bfu* Qg = reinterpret_cast<bfu*>(P.ws + O_QG);
  bfu* Kg = reinterpret_cast<bfu*>(P.ws + O_KG);
  bfu* Vg = reinterpret_cast<bfu*>(P.ws + O_VG);
  const float gq = P.gqa_q_norm[layer * 64 + lane], gk = P.gqa_k_norm[layer * 64 + lane];
  for (int row0 = gw; row0 < MT; row0 += 4 * nw) {
    u32x2 wq[4]; unsigned wkv[4]; bfu xq[4][6], xk[4][2], xvv[4][2], xkr[4]; float csg[4], sng[4], c2m[4], s2m[4];
#pragma unroll
    for (int q = 0; q < 4; ++q) {
      const int row = row0 + q * nw;
      if (row < MT) {
        int b, t, v; rowinfo(row, b, t, v);
        const bfu* pr = pbuf + (size_t)row * INC;
        wq[q] = *reinterpret_cast<const u32x2*>(pr + PC_MLAQ + lane * 4);
        wkv[q] = *reinterpret_cast<const unsigned*>(pr + PC_KV + lane * 2);
#pragma unroll
        for (int h = 0; h < 6; ++h) xq[q][h] = pr[PC_GQ + h * 64 + lane];
#pragma unroll
        for (int g = 0; g < 2; ++g) { xk[q][g] = pr[PC_GK + g * 64 + lane]; xvv[q][g] = pr[PC_GV + g * 64 + lane]; }
        xkr[q] = pr[PC_KR + (lane & 31)];
        csg[q] = 1.f; sng[q] = 0.f; c2m[q] = 1.f; s2m[q] = 0.f;
        if (row < ML) {
          { const int sec = lane >> 5, i = lane & 15; const int pos = sec ? (t & 63) : (t >> 6); csg[q] = rt[1024 + pos * 16 + i]; sng[q] = rt[2048 + pos * 16 + i]; }
          { const int e = lane & 31; const int sec = (e >> 4) & 1, i = e & 7; const int pos = sec ? (t & 63) : (t >> 6); c2m[q] = rt[pos * 8 + i]; s2m[q] = rt[512 + pos * 8 + i]; }
        }
      }
    }
#pragma unroll
    for (int q = 0; q < 4; ++q) {
      const int row = row0 + q * nw;
      if (row < MT) {
        int b, t, v; rowinfo(row, b, t, v);
        const bool latent = row < ML;
        {
          float a0 = bflo(wq[q][0]), a1 = bfhi(wq[q][0]), a2 = bflo(wq[q][1]), a3 = bfhi(wq[q][1]);
          float sq = wsum(a0 * a0 + a1 * a1 + a2 * a2 + a3 * a3);
          float c0 = bflo(wkv[q]), c1 = bfhi(wkv[q]);
          float sk = wsum(c0 * c0 + c1 * c1);
          if (lane == 0) { stats[row * 2] = rsqrtf(sq * (1.f / 256.f) + EPS); stats[row * 2 + 1] = rsqrtf(sk * (1.f / 128.f) + EPS); }
        }
        const float cs = csg[q], sn = sng[q];
        const bool firstg = !(lane & 16);
        if (latent || !last) {
#pragma unroll
          for (int h = 0; h < 6; ++h) {
            float x = bf2f(xq[q][h]);
            float ss = wsum(x * x);
            float xn = x * rsqrtf(ss * (1.f / 64.f) + EPS) * gq;
            float pn = swz_xor<16>(xn);
            float o = firstg ? (xn * cs - pn * sn) : (pn * sn + xn * cs);
            Qg[((size_t)(b * 6 + h) * TK + t) * 64 + lane] = f2bf(o * QS_G);
          }
        }
#pragma unroll
        for (int g = 0; g < 2; ++g) {
          float x = bf2f(xk[q][g]);
          float ss = wsum(x * x);
          float xn = x * rsqrtf(ss * (1.f / 64.f) + EPS) * gk;
          float pn = swz_xor<16>(xn);
          float o = firstg ? (xn * cs - pn * sn) : (pn * sn + xn * cs);
          Kg[((size_t)(b * 2 + g) * TK + t) * 64 + lane] = f2bf(o);
          Vg[((size_t)(b * 2 + g) * TK + t) * 64 + lane] = xvv[q][g];
        }
        {
          const int e = lane & 31;
          float x = bf2f(xkr[q]);
          float pn = swz_xor<8>(x);
          float o = !(e & 8) ? (x * c2m[q] - pn * s2m[q]) : (pn * s2m[q] + x * c2m[q]);
          const bfu ob = f2bf(o);
          const int hb = lane >> 5;
#pragma unroll
          for (int hh = 0; hh < 3; ++hh) Km[((size_t)(b * 6 + hh * 2 + hb) * TK + t) * 96 + 64 + e] = ob;
        }
      }
    }
  }
  float* yb = reinterpret_cast<float*>(lds);
  float* ob = yb + 62 * 256;
  bfu* z = reinterpret_cast<bfu*>(P.ws + O_Z);
  const int ntl = NB * 128, ntc = last ? 0 : NB * 8;
  const int c = tid & 255, hf = tid >> 8;
  for (int tile = blockIdx.x; tile < ntl + ntc; tile += gridDim.x) {
    int rowbase, seqlen, t0;
    if (tile < ntl) { const int b = tile >> 7; rowbase = b * SEQ; seqlen = SEQ; t0 = (tile & 127) * 32; }
    else { const int tt = tile - ntl; const int b = tt >> 3; rowbase = ML + b * CTX; seqlen = CTX; t0 = (tt & 7) * 32; }
    __syncthreads();
    for (int idx = tid; idx < 62 * 32; idx += NTHR) {
      const int tr = idx >> 5, ch = idx & 31, tt = t0 - 15 + tr;
      f32x4 o0 = {0.f, 0.f, 0.f, 0.f}, o1 = {0.f, 0.f, 0.f, 0.f};
      if (tt >= 0 && tt < seqlen) {
        const bfu* pr = pbuf + (size_t)(rowbase + tt) * INC + PC_CONV + ch * 8;
        u32x4 a = *reinterpret_cast<const u32x4*>(pr), g = *reinterpret_cast<const u32x4*>(pr + 256);
#pragma unroll
        for (int j = 0; j < 4; ++j) {
          float al = bflo(a[j]), ah = bfhi(a[j]), gl = bflo(g[j]), gh = bfhi(g[j]);
          float yl = al * __builtin_amdgcn_rcpf(1.f + __expf(-gl)), yh = ah * __builtin_amdgcn_rcpf(1.f + __expf(-gh));
          if (j < 2) { o0[j * 2] = yl; o0[j * 2 + 1] = yh; } else { o1[(j - 2) * 2] = yl; o1[(j - 2) * 2 + 1] = yh; }
        }
      }
      *reinterpret_cast<f32x4*>(yb + tr * 256 + ch * 8) = o0;
      *reinterpret_cast<f32x4*>(yb + tr * 256 + ch * 8 + 4) = o1;
    }
    __syncthreads();
    {
      float acc[16];
      const float bias = P.conv_dw_b[layer * 256 + c];
#pragma unroll
      for (int i = 0; i < 16; ++i) acc[i] = bias;
      const float* wp = P.conv_dw_w + (size_t)layer * 31 * 256 + c;
      const float* yp = yb + (hf * 16) * 256 + c;
#pragma unroll
      for (int j = 0; j < 46; ++j) {
        const float yv = yp[j * 256];
#pragma unroll
        for (int i = 0; i < 16; ++i) {
          const int tap = j - i;
          if (tap >= 0 && tap < 31) acc[i] += wp[tap * 256] * yv;
        }
      }
#pragma unroll
      for (int i = 0; i < 16; ++i) ob[(hf * 16 + i) * 256 + c] = acc[i];
    }
    __syncthreads();
    {
      const f32x4 lw = *reinterpret_cast<const f32x4*>(P.conv_ln_w + layer * 256 + lane * 4);
      const f32x4 lb = *reinterpret_cast<const f32x4*>(P.conv_ln_b + layer * 256 + lane * 4);
#pragma unroll
      for (int q = 0; q < 4; ++q) {
        const int tok = wid * 4 + q;
        f32x4 v = *reinterpret_cast<const f32x4*>(ob + tok * 256 + lane * 4);
        const float mu = wsum(v[0] + v[1] + v[2] + v[3]) * (1.f / 256.f);
        const float d0 = v[0] - mu, d1 = v[1] - mu, d2 = v[2] - mu, d3 = v[3] - mu;
        const float var = wsum(d0 * d0 + d1 * d1 + d2 * d2 + d3 * d3) * (1.f / 256.f);
        const float rs = rsqrtf(var + EPS);
        const float n0 = siluf(d0 * rs * lw[0] + lb[0]), n1 = siluf(d1 * rs * lw[1] + lb[1]), n2 = siluf(d2 * rs * lw[2] + lb[2]), n3 = siluf(d3 * rs * lw[3] + lb[3]);
        u32x2 w = {pk2(n0, n1), pk2(n2, n3)};
        *reinterpret_cast<u32x2*>(z + (size_t)(rowbase + t0 + tok) * 256 + lane * 4) = w;
      }
    }
  }
  __syncthreads();
}

DEVI void phase_gemm_mid(int wv, const Params& P, int layer, bool last, char* lds) {
  const int tid = otid(wv);
  const bfu* pbuf = reinterpret_cast<const bfu*>(P.ws + O_P);
  const bfu* Wuq = reinterpret_cast<const bfu*>(P.ws + O_WUQ + layer * SZ_WUQ);
  const bfu* Wukv = reinterpret_cast<const bfu*>(P.ws + O_WUKV + layer * SZ_WUKV);
  const bfu* Wpw = reinterpret_cast<const bfu*>(P.ws + O_WPW + layer * SZ_WPW);
  const bfu* z = reinterpret_cast<const bfu*>(P.ws + O_Z);
  constexpr int PANELS = MT / 256, SUB = 13;
  int grp, loc, per, ngrp; blk_group(grp, loc, per, ngrp);
  const int PG = PANELS / ngrp, g0 = grp * PG;
  const NextTile none{nullptr, nullptr, 0, 0, 0, 0, false};
  for (int tl = loc; tl < PG * SUB; tl += per) {
    const int pm = g0 + tl / SUB, sub = tl % SUB, m0 = pm * 256;
    const bool ctxp = m0 >= ML;
    u32x4 ra[4], rb[2];
    if (sub < 5) { if (!(last && ctxp)) gemm_tile<EPI_Q, 2>(pbuf + PC_MLAQ, INC, Wuq, 256, 256, m0, sub * 128, lds, P, layer, tid, ra, rb, false, none); }
    else if (sub < 11) gemm_tile<EPI_KV, 2>(pbuf + PC_KV, INC, Wukv, 128, 128, m0, (sub - 5) * 128, lds, P, layer, tid, ra, rb, false, none);
    else { if (!(last && ctxp)) gemm_tile<EPI_CONV, 2>(z, 256, Wpw, 256, 256, m0, (sub - 11) * 128, lds, P, layer, tid, ra, rb, false, none); }
  }
}

DEVI int v_st(int k, int c) { return ((k >> 3) * 2 + (c >> 5)) * 512 + ((k & 7) * 32 + (c & 31)) * 2; }
DEVI int v_rd_base(int lane) { return ((lane & 3) << 3) | (((lane >> 2) & 3) << 6) | (((lane >> 4) & 1) << 5) | (((lane >> 5) & 1) << 8); }
constexpr int v_rd_off(int d0, int ks, int half) { return d0 * 512 + ks * 2048 + half * 1024; }
template <int OFF> DEVI s16x4 tr_read(int vb) {
  s16x4 r; asm volatile("ds_read_b64_tr_b16 %0, %1 offset:%2" : "=&v"(r) : "v"(vb), "i"(OFF) : "memory"); return r;
}
#define SBAR() __builtin_amdgcn_sched_barrier(0)

DEVI void pv_all(f32x16& oa, f32x16& ob, int vb, bf16x8 pa0, bf16x8 pa1, bf16x8 pa2, bf16x8 pa3) {
#define PK(L, H) (bf16x8){L[0], L[1], L[2], L[3], H[0], H[1], H[2], H[3]}
  const s16x4 a0 = tr_read<v_rd_off(0, 0, 0)>(vb), b0 = tr_read<v_rd_off(0, 0, 1)>(vb), c0 = tr_read<v_rd_off(1, 0, 0)>(vb), d0 = tr_read<v_rd_off(1, 0, 1)>(vb);
  const s16x4 a1 = tr_read<v_rd_off(0, 1, 0)>(vb), b1 = tr_read<v_rd_off(0, 1, 1)>(vb), c1 = tr_read<v_rd_off(1, 1, 0)>(vb), d1 = tr_read<v_rd_off(1, 1, 1)>(vb);
  const s16x4 a2 = tr_read<v_rd_off(0, 2, 0)>(vb), b2 = tr_read<v_rd_off(0, 2, 1)>(vb), c2 = tr_read<v_rd_off(1, 2, 0)>(vb), d2 = tr_read<v_rd_off(1, 2, 1)>(vb);
  const s16x4 a3 = tr_read<v_rd_off(0, 3, 0)>(vb), b3 = tr_read<v_rd_off(0, 3, 1)>(vb), c3 = tr_read<v_rd_off(1, 3, 0)>(vb), d3 = tr_read<v_rd_off(1, 3, 1)>(vb);
  asm volatile("s_waitcnt lgkmcnt(0)" ::: "memory"); SBAR();
  oa = mfma32(PK(a0, b0), pa0, oa); ob = mfma32(PK(c0, d0), pa0, ob);
  oa = mfma32(PK(a1, b1), pa1, oa); ob = mfma32(PK(c1, d1), pa1, ob);
  oa = mfma32(PK(a2, b2), pa2, oa); ob = mfma32(PK(c2, d2), pa2, ob);
  oa = mfma32(PK(a3, b3), pa3, oa); ob = mfma32(PK(c3, d3), pa3, ob);
#undef PK
}

template <bool FAST> DEVI void partialSM(f32x16& p0, f32x16& p1, float& m_reg, float& alpha) {
  if constexpr (FAST) { alpha = 1.f; return; }
  float pmax = p0[0];
#pragma unroll
  for (int r = 1; r < 16; ++r) pmax = fmaxf(pmax, p0[r]);
#pragma unroll
  for (int r = 0; r < 16; ++r) pmax = fmaxf(pmax, p1[r]);
  { auto rr = __builtin_amdgcn_permlane32_swap(__float_as_uint(pmax), __float_as_uint(pmax), false, false);
    pmax = fmaxf(__uint_as_float(rr[0]), __uint_as_float(rr[1])); }
  if (__all(pmax <= m_reg)) { alpha = 1.f; }
  else { const float mn = fmaxf(m_reg, pmax); alpha = __builtin_amdgcn_exp2f(m_reg - mn); m_reg = mn; }
#pragma unroll
  for (int r = 0; r < 16; ++r) p0[r] = __builtin_amdgcn_exp2f(p0[r] - m_reg);
#pragma unroll
  for (int r = 0; r < 16; ++r) p1[r] = p1[r] - m_reg;
}
template <bool FAST> DEVI void finishSM(f32x16& p0, f32x16& p1, float alpha, float& l_reg, bf16x8& pa0, bf16x8& pa1, bf16x8& pa2, bf16x8& pa3) {
  if constexpr (FAST) {
#pragma unroll
    for (int r = 0; r < 16; ++r) p0[r] = __builtin_amdgcn_exp2f(p0[r]);
  }
#pragma unroll
  for (int r = 0; r < 16; ++r) p1[r] = __builtin_amdgcn_exp2f(p1[r]);
  float ps = 0.f;
#pragma unroll
  for (int r = 0; r < 16; ++r) ps += p0[r];
#pragma unroll
  for (int r = 0; r < 16; ++r) ps += p1[r];
  if constexpr (FAST) { l_reg += ps; }
  else {
  { auto rr = __builtin_amdgcn_permlane32_swap(__float_as_uint(ps), __float_as_uint(ps), false, false);
    ps = __uint_as_float(rr[0]) + __uint_as_float(rr[1]); }
  l_reg = l_reg * alpha + ps;
  }
#define PK8(P, BASE, OUT) do { u32x4 w = {cvtpk(P[BASE + 0], P[BASE + 1]), cvtpk(P[BASE + 2], P[BASE + 3]), cvtpk(P[BASE + 4], P[BASE + 5]), cvtpk(P[BASE + 6], P[BASE + 7])}; \
    OUT = *reinterpret_cast<bf16x8*>(&w); } while (0)
  PK8(p0, 0, pa0); PK8(p0, 8, pa1); PK8(p1, 0, pa2); PK8(p1, 8, pa3);
#undef PK8
}

template <int DQK>
DEVI void qkt(f32x16& p0, f32x16& p1, const char* Ks, const bf16x8* qr, int r32, int hi) {
  constexpr int KROW = DQK * 2 + 16, ND = DQK / 16;
#pragma unroll
  for (int r = 0; r < 16; ++r) { p0[r] = 0.f; p1[r] = 0.f; }
  const char* ka = Ks + r32 * KROW + hi * 16;
  const char* kb = Ks + (32 + r32) * KROW + hi * 16;
  bf16x8 x0 = *reinterpret_cast<const bf16x8*>(ka), x1 = *reinterpret_cast<const bf16x8*>(kb), y0, y1;
#pragma unroll
  for (int d0 = 0; d0 < ND; d0 += 2) {
    if (d0 + 1 < ND) { y0 = *reinterpret_cast<const bf16x8*>(ka + (d0 + 1) * 32); y1 = *reinterpret_cast<const bf16x8*>(kb + (d0 + 1) * 32); }
    SBAR();
    p0 = mfma32(x0, qr[d0], p0); p1 = mfma32(x1, qr[d0], p1);
    SBAR();
    if (d0 + 1 < ND) {
      if (d0 + 2 < ND) { x0 = *reinterpret_cast<const bf16x8*>(ka + (d0 + 2) * 32); x1 = *reinterpret_cast<const bf16x8*>(kb + (d0 + 2) * 32); }
      SBAR();
      p0 = mfma32(y0, qr[d0 + 1], p0); p1 = mfma32(y1, qr[d0 + 1], p1);
      SBAR();
    }
  }
}

template <int DQK, bool FAST>
DEVI bool attn_unit(const bfu* __restrict__ Q, const bfu* __restrict__ Kh, const bfu* __restrict__ Vh, int nkeys,
                    const bfu* __restrict__ pg, bfu* __restrict__ yo, char* lds, int tid) {
  constexpr int KROW = DQK * 2 + 16, KT_BYTES = 64 * KROW, VT_BYTES = 8192, KCH = 64 * (DQK / 8);
  constexpr int CPR = DQK / 8;
  const int wid = tid >> 6, lane = tid & 63, r32 = lane & 31, hi = lane >> 5;
  char* K_lds = lds; char* V_lds = lds + 3 * KT_BYTES;
  float m_reg = -1e30f, l_reg = 0.f;
  f32x16 o0, o1;
#pragma unroll
  for (int r = 0; r < 16; ++r) { o0[r] = 0.f; o1[r] = 0.f; }
  bf16x8 qr[DQK / 16];
  {
    const bfu* Qw = Q + (size_t)(wid * 32 + r32) * DQK + hi * 8;
#pragma unroll
    for (int d0 = 0; d0 < DQK / 16; ++d0) qr[d0] = *reinterpret_cast<const bf16x8*>(Qw + d0 * 16);
  }
  const bool k2 = (tid + 512) < KCH;
  const int kq0 = tid, kq1 = tid + 512;
  const int kst0 = (kq0 / CPR) * KROW + (kq0 % CPR) * 16, kst1 = (kq1 / CPR) * KROW + (kq1 % CPR) * 16;
  const int vst = v_st(tid >> 3, (tid & 7) * 8);
  const int vb0 = (int)(uintptr_t)V_lds + v_rd_base(lane);
  u32x4 sk0, sk1, sv;
  sk1 = u32x4{0u, 0u, 0u, 0u};
#define SLOAD(kt) do { const bfu* kp_ = Kh + (size_t)(kt) * 64 * DQK; sk0 = *reinterpret_cast<const u32x4*>(kp_ + kq0 * 8); \
    if (k2) sk1 = *reinterpret_cast<const u32x4*>(kp_ + kq1 * 8); sv = *reinterpret_cast<const u32x4*>(Vh + (size_t)(kt) * 64 * 64 + tid * 8); } while (0)
#define SWRITE(s) do { *reinterpret_cast<u32x4*>(K_lds + (s) * KT_BYTES + kst0) = sk0; if (k2) *reinterpret_cast<u32x4*>(K_lds + (s) * KT_BYTES + kst1) = sk1; \
    *reinterpret_cast<u32x4*>(V_lds + (s) * VT_BYTES + vst) = sv; } while (0)
#define RESC(a) do { if constexpr (!FAST) if (__any((a) < 1.f)) { _Pragma("unroll") for (int r = 0; r < 16; ++r) { o0[r] *= (a); o1[r] *= (a); } } } while (0)
  f32x16 pA0, pA1, pB0, pB1; float alA, alB; bf16x8 pa0, pa1, pa2, pa3;
  const int NT = nkeys / 64;
  __syncthreads();
  SLOAD(0); SWRITE(0); SLOAD(1);
  __syncthreads();
  SWRITE(1); SLOAD(2);
  qkt<DQK>(pA0, pA1, K_lds, qr, r32, hi); partialSM<FAST>(pA0, pA1, m_reg, alA);
  __syncthreads();
  int sa = 0, sb = 1, sc = 2;
  for (int j = 1; j + 1 < NT; j += 2) {
    SWRITE(sc); if (j + 2 < NT) SLOAD(j + 2);
    SBAR(); qkt<DQK>(pB0, pB1, K_lds + sb * KT_BYTES, qr, r32, hi); if constexpr (FAST) SBAR();
    finishSM<FAST>(pA0, pA1, alA, l_reg, pa0, pa1, pa2, pa3); SBAR();
    pv_all(o0, o1, vb0 + sa * VT_BYTES, pa0, pa1, pa2, pa3);
    partialSM<FAST>(pB0, pB1, m_reg, alB); RESC(alB);
    __syncthreads();
    SWRITE(sa); if (j + 3 < NT) SLOAD(j + 3);
    SBAR(); qkt<DQK>(pA0, pA1, K_lds + sc * KT_BYTES, qr, r32, hi); if constexpr (FAST) SBAR();
    finishSM<FAST>(pB0, pB1, alB, l_reg, pa0, pa1, pa2, pa3); SBAR();
    pv_all(o0, o1, vb0 + sb * VT_BYTES, pa0, pa1, pa2, pa3);
    partialSM<FAST>(pA0, pA1, m_reg, alA); RESC(alA);
    __syncthreads();
    { const int t_ = sa; sa = sc; sc = sb; sb = t_; }
  }
  SBAR(); qkt<DQK>(pB0, pB1, K_lds + sb * KT_BYTES, qr, r32, hi);
  finishSM<FAST>(pA0, pA1, alA, l_reg, pa0, pa1, pa2, pa3); SBAR();
  pv_all(o0, o1, vb0 + sa * VT_BYTES, pa0, pa1, pa2, pa3);
  partialSM<FAST>(pB0, pB1, m_reg, alB); RESC(alB);
  finishSM<FAST>(pB0, pB1, alB, l_reg, pa0, pa1, pa2, pa3); SBAR();
  pv_all(o0, o1, vb0 + sb * VT_BYTES, pa0, pa1, pa2, pa3);
#undef SLOAD
#undef SWRITE
#undef RESC
  if constexpr (FAST) {
    { auto rr = __builtin_amdgcn_permlane32_swap(__float_as_uint(l_reg), __float_as_uint(l_reg), false, false);
      l_reg = __uint_as_float(rr[0]) + __uint_as_float(rr[1]); }
    const int bad = !(l_reg > 1e-30f && l_reg < 1e30f);
    const int wbad = __any(bad) ? 1 : 0;
    __syncthreads();
    if (lane == 0) reinterpret_cast<int*>(lds)[wid] = wbad;
    __syncthreads();
    int anyb = 0;
#pragma unroll
    for (int w = 0; w < NTHR / 64; ++w) anyb |= reinterpret_cast<const int*>(lds)[w];
    if (anyb) return false;
  }
  const float inv = 1.f / l_reg;
  const int qrow = wid * 32 + r32;
  const bfu* pgr = pg + (size_t)qrow * INC;
  bfu* yr = yo + (size_t)qrow * 1024;
#pragma unroll
  for (int g4 = 0; g4 < 4; ++g4) {
    const int cbase = 8 * g4 + 4 * hi;
    {
      u32x2 gw = *reinterpret_cast<const u32x2*>(pgr + cbase);
      float a0 = o0[g4 * 4 + 0] * inv * siluf(bflo(gw[0])), a1 = o0[g4 * 4 + 1] * inv * siluf(bfhi(gw[0]));
      float a2 = o0[g4 * 4 + 2] * inv * siluf(bflo(gw[1])), a3 = o0[g4 * 4 + 3] * inv * siluf(bfhi(gw[1]));
      u32x2 w = {pk2(a0, a1), pk2(a2, a3)};
      *reinterpret_cast<u32x2*>(yr + cbase) = w;
    }
    {
      u32x2 gw = *reinterpret_cast<const u32x2*>(pgr + 32 + cbase);
      float a0 = o1[g4 * 4 + 0] * inv * siluf(bflo(gw[0])), a1 = o1[g4 * 4 + 1] * inv * siluf(bfhi(gw[0]));
      float a2 = o1[g4 * 4 + 2] * inv * siluf(bflo(gw[1])), a3 = o1[g4 * 4 + 3] * inv * siluf(bfhi(gw[1]));
      u32x2 w = {pk2(a0, a1), pk2(a2, a3)};
      *reinterpret_cast<u32x2*>(yr + 32 + cbase) = w;
    }
  }
  return true;
}

template <int DQK>
DEVI bool attn_unit_ks(const bfu* __restrict__ Q, const bfu* __restrict__ Kh, const bfu* __restrict__ Vh, int nkeys,
                       const bfu* __restrict__ pg, bfu* __restrict__ yo, char* lds, int tid) {
  constexpr int KROW = DQK * 2 + 16, KT_BYTES = 64 * KROW, VT_BYTES = 8192, KCH = 64 * (DQK / 8), CPR = DQK / 8, ND = DQK / 16;
  const int wid = tid >> 6, lane = tid & 63, r32 = lane & 31, hi = lane >> 5;
  const int qg = wid >> 1, kh = wid & 1;
  char* K_lds = lds; char* V_lds = lds + 3 * KT_BYTES;
  float l0 = 0.f, l1 = 0.f;
  f32x16 o00, o01, o10, o11;
#pragma unroll
  for (int r = 0; r < 16; ++r) { o00[r] = 0.f; o01[r] = 0.f; o10[r] = 0.f; o11[r] = 0.f; }
  bf16x8 qa[ND], qb[ND];
  {
    const bfu* Qw = Q + (size_t)(qg * 64 + r32) * DQK + hi * 8;
#pragma unroll
    for (int d0 = 0; d0 < ND; ++d0) { qa[d0] = *reinterpret_cast<const bf16x8*>(Qw + d0 * 16); qb[d0] = *reinterpret_cast<const bf16x8*>(Qw + 32 * DQK + d0 * 16); }
  }
  const bool k2 = (tid + 512) < KCH;
  const int kq0 = tid, kq1 = tid + 512;
  const int kst0 = (kq0 / CPR) * KROW + (kq0 % CPR) * 16, kst1 = (kq1 / CPR) * KROW + (kq1 % CPR) * 16;
  const int vst = v_st(tid >> 3, (tid & 7) * 8);
  const int vb0 = (int)(uintptr_t)V_lds + kh * 4096 + v_rd_base(lane);
  const int kfo = (kh * 32 + r32) * KROW + hi * 16;
  u32x4 sk0, sk1, sv;
  sk1 = u32x4{0u, 0u, 0u, 0u};
  const unsigned ko0 = (unsigned)kq0 * 16u, ko1 = (unsigned)kq1 * 16u, vo0 = (unsigned)tid * 16u;
#define SLOAD(kt) do { const char* kp_ = reinterpret_cast<const char*>(Kh) + (size_t)(kt) * (64 * DQK * 2); sk0 = *reinterpret_cast<const u32x4*>(kp_ + ko0); \
    if (k2) sk1 = *reinterpret_cast<const u32x4*>(kp_ + ko1); sv = *reinterpret_cast<const u32x4*>(reinterpret_cast<const char*>(Vh) + (size_t)(kt) * (64 * 64 * 2) + vo0); } while (0)
#define SWRITE(s) do { *reinterpret_cast<u32x4*>(K_lds + (s) * KT_BYTES + kst0) = sk0; if (k2) *reinterpret_cast<u32x4*>(K_lds + (s) * KT_BYTES + kst1) = sk1; \
    *reinterpret_cast<u32x4*>(V_lds + (s) * VT_BYTES + vst) = sv; } while (0)
  const int NT = nkeys / 64;
  __syncthreads();
  SLOAD(0); SWRITE(0); SLOAD(1);
  __syncthreads();
  int slot = 0, wslot = 1;
  for (int j = 0; j < NT; ++j) {
    if (j + 1 < NT) SWRITE(wslot);
    if (j + 2 < NT) SLOAD(j + 2);
    f32x16 pA, pB;
#pragma unroll
    for (int r = 0; r < 16; ++r) { pA[r] = 0.f; pB[r] = 0.f; }
    {
      const char* kp = K_lds + slot * KT_BYTES + kfo;
#pragma unroll
      for (int d0 = 0; d0 < ND; ++d0) {
        const bf16x8 kx = *reinterpret_cast<const bf16x8*>(kp + d0 * 32);
        pA = mfma32(kx, qa[d0], pA); pB = mfma32(kx, qb[d0], pB);
      }
    }
    float psA = 0.f, psB = 0.f;
#pragma unroll
    for (int r = 0; r < 16; ++r) { pA[r] = __builtin_amdgcn_exp2f(pA[r]); pB[r] = __builtin_amdgcn_exp2f(pB[r]); }
#pragma unroll
    for (int r = 0; r < 16; ++r) { psA += pA[r]; psB += pB[r]; }
    l0 += psA; l1 += psB;
    bf16x8 fA0, fA1, fB0, fB1;
#define PK8(P, BASE, OUT) do { u32x4 w = {cvtpk(P[BASE + 0], P[BASE + 1]), cvtpk(P[BASE + 2], P[BASE + 3]), cvtpk(P[BASE + 4], P[BASE + 5]), cvtpk(P[BASE + 6], P[BASE + 7])}; \
    OUT = *reinterpret_cast<bf16x8*>(&w); } while (0)
    PK8(pA, 0, fA0); PK8(pA, 8, fA1); PK8(pB, 0, fB0); PK8(pB, 8, fB1);
#undef PK8
    SBAR();
    {
      const int vb = vb0 + slot * VT_BYTES;
#define PK(L, H) (bf16x8){L[0], L[1], L[2], L[3], H[0], H[1], H[2], H[3]}
      {
        const s16x4 a0 = tr_read<v_rd_off(0, 0, 0)>(vb), b0 = tr_read<v_rd_off(0, 0, 1)>(vb), c0 = tr_read<v_rd_off(1, 0, 0)>(vb), d0_ = tr_read<v_rd_off(1, 0, 1)>(vb);
        asm volatile("s_waitcnt lgkmcnt(0)" ::: "memory"); SBAR();
        const bf16x8 v00 = PK(a0, b0), v10 = PK(c0, d0_);
        o00 = mfma32(v00, fA0, o00); o01 = mfma32(v10, fA0, o01); o10 = mfma32(v00, fB0, o10); o11 = mfma32(v10, fB0, o11);
      }
      SBAR();
      {
        const s16x4 a1 = tr_read<v_rd_off(0, 1, 0)>(vb), b1 = tr_read<v_rd_off(0, 1, 1)>(vb), c1 = tr_read<v_rd_off(1, 1, 0)>(vb), d1_ = tr_read<v_rd_off(1, 1, 1)>(vb);
        asm volatile("s_waitcnt lgkmcnt(0)" ::: "memory"); SBAR();
        const bf16x8 v01 = PK(a1, b1), v11 = PK(c1, d1_);
        o00 = mfma32(v01, fA1, o00); o01 = mfma32(v11, fA1, o01); o10 = mfma32(v01, fB1, o10); o11 = mfma32(v11, fB1, o11);
      }
#undef PK
    }
    __syncthreads();
    slot = (slot == 2) ? 0 : slot + 1; wslot = (wslot == 2) ? 0 : wslot + 1;
  }
#undef SLOAD
#undef SWRITE
  float* cbuf = reinterpret_cast<float*>(lds);
  float* mine = cbuf + wid * (33 * 64) + lane;
  const float* theirs = cbuf + (wid ^ 1) * (33 * 64) + lane;
  f32x16 o0, o1; float l_reg;
  if (kh) {
#pragma unroll
    for (int r = 0; r < 16; ++r) { mine[r * 64] = o00[r]; mine[(16 + r) * 64] = o01[r]; }
    mine[32 * 64] = l0;
    o0 = o10; o1 = o11; l_reg = l1;
  } else {
#pragma unroll
    for (int r = 0; r < 16; ++r) { mine[r * 64] = o10[r]; mine[(16 + r) * 64] = o11[r]; }
    mine[32 * 64] = l1;
    o0 = o00; o1 = o01; l_reg = l0;
  }
  __syncthreads();
#pragma unroll
  for (int r = 0; r < 16; ++r) { o0[r] += theirs[r * 64]; o1[r] += theirs[(16 + r) * 64]; }
  l_reg += theirs[32 * 64];
  { auto rr = __builtin_amdgcn_permlane32_swap(__float_as_uint(l_reg), __float_as_uint(l_reg), false, false);
    l_reg = __uint_as_float(rr[0]) + __uint_as_float(rr[1]); }
  {
    const int bad = !(l_reg > 1e-30f && l_reg < 1e30f);
    const int wbad = __any(bad) ? 1 : 0;
    __syncthreads();
    if (lane == 0) reinterpret_cast<int*>(lds)[wid] = wbad;
    __syncthreads();
    int anyb = 0;
#pragma unroll
    for (int w = 0; w < NTHR / 64; ++w) anyb |= reinterpret_cast<const int*>(lds)[w];
    if (anyb) return false;
  }
  const float inv = 1.f / l_reg;
  const int qrow = qg * 64 + kh * 32 + r32;
  const bfu* pgr = pg + (size_t)qrow * INC;
  bfu* yr = yo + (size_t)qrow * 1024;
#pragma unroll
  for (int g4 = 0; g4 < 4; ++g4) {
    const int cbase = 8 * g4 + 4 * hi;
    {
      u32x2 gw = *reinterpret_cast<const u32x2*>(pgr + cbase);
      float a0 = o0[g4 * 4 + 0] * inv * siluf(bflo(gw[0])), a1 = o0[g4 * 4 + 1] * inv * siluf(bfhi(gw[0]));
      float a2 = o0[g4 * 4 + 2] * inv * siluf(bflo(gw[1])), a3 = o0[g4 * 4 + 3] * inv * siluf(bfhi(gw[1]));
      u32x2 w = {pk2(a0, a1), pk2(a2, a3)};
      *reinterpret_cast<u32x2*>(yr + cbase) = w;
    }
    {
      u32x2 gw = *reinterpret_cast<const u32x2*>(pgr + 32 + cbase);
      float a0 = o1[g4 * 4 + 0] * inv * siluf(bflo(gw[0])), a1 = o1[g4 * 4 + 1] * inv * siluf(bfhi(gw[0]));
      float a2 = o1[g4 * 4 + 2] * inv * siluf(bflo(gw[1])), a3 = o1[g4 * 4 + 3] * inv * siluf(bfhi(gw[1]));
      u32x2 w = {pk2(a0, a1), pk2(a2, a3)};
      *reinterpret_cast<u32x2*>(yr + 32 + cbase) = w;
    }
  }
  return true;
}

template <bool FAST> DEVI bool attn_dispatch(const Params& P, int b, int head12, int qb, bool ctxq, char* lds, int tid) {
  const bfu* pbuf = reinterpret_cast<const bfu*>(P.ws + O_P);
  bfu* yb = reinterpret_cast<bfu*>(P.ws + O_H);
  const int t0 = ctxq ? SEQ : qb * 256;
  const int row0 = ctxq ? ML + b * CTX : b * SEQ + qb * 256;
  const int kt0 = ctxq ? SEQ : 0, nkeys = ctxq ? CTX : TK;
  if (head12 < 6) {
    const int h = head12;
    const bfu* Q = reinterpret_cast<const bfu*>(P.ws + O_QM) + ((size_t)(b * 6 + h) * TK + t0) * 96;
    const bfu* K = reinterpret_cast<const bfu*>(P.ws + O_KM) + ((size_t)(b * 6 + h) * TK + kt0) * 96;
    const bfu* V = reinterpret_cast<const bfu*>(P.ws + O_VM) + ((size_t)(b * 6 + h) * TK + kt0) * 64;
    return attn_unit<96, FAST>(Q, K, V, nkeys, pbuf + (size_t)row0 * INC + PC_GATE + h * 64, yb + (size_t)row0 * 1024 + h * 64, lds, tid);
  } else {
    const int h = head12 - 6, g = h / 3;
    const bfu* Q = reinterpret_cast<const bfu*>(P.ws + O_QG) + ((size_t)(b * 6 + h) * TK + t0) * 64;
    const bfu* K = reinterpret_cast<const bfu*>(P.ws + O_KG) + ((size_t)(b * 2 + g) * TK + kt0) * 64;
    const bfu* V = reinterpret_cast<const bfu*>(P.ws + O_VG) + ((size_t)(b * 2 + g) * TK + kt0) * 64;
    return attn_unit<64, FAST>(Q, K, V, nkeys, pbuf + (size_t)row0 * INC + PC_GATE + 384 + h * 64, yb + (size_t)row0 * 1024 + 384 + h * 64, lds, tid);
  }
}

template <bool FAST> DEVI unsigned phase_attn(int wv, const Params& P, bool last, char* lds, unsigned mask) {
  const int tid = otid(wv);
  int grp, loc, per, ngrp; blk_group(grp, loc, per, ngrp);
  const int UL = (NB / ngrp) * 192, UC = last ? 0 : (NB / ngrp) * 12;
  unsigned bad = 0u; int k = 0;
  for (int u = loc; u < UL + UC; u += per, ++k) {
    if (!FAST && !((mask >> (k & 31)) & 1u)) continue;
    bool ok;
    if (u < UL) { const int ug = grp * UL + u; ok = attn_dispatch<FAST>(P, ug / 192, (ug % 192) >> 4, ug & 15, false, lds, tid); }
    else { const int ug = grp * UC + (u - UL); ok = attn_dispatch<FAST>(P, ug / 12, ug % 12, 0, true, lds, tid); }
    if (!ok) bad |= 1u << (k & 31);
  }
  return bad;
}

DEVI void phase_gemm_out(int wv, const Params& P, int layer, bool last, char* lds) {
  const int tid = otid(wv);
  const bfu* A = reinterpret_cast<const bfu*>(P.ws + O_H);
  const bfu* Bt = reinterpret_cast<const bfu*>(P.ws + O_WOUT + layer * SZ_WOUT);
  const int PANELS = last ? ML / 256 : MT / 256;
  constexpr int NT = 8;
  int grp, loc, per, ngrp; blk_group(grp, loc, per, ngrp);
  const int PG = PANELS / ngrp, g0 = grp * PG;
  u32x4 ra[4], rb[2]; bool pref = false;
  for (int tl = loc; tl < PG * NT; tl += per) {
    const int tn = tl + per;
    NextTile nx{A, Bt, 1024, 1024, (g0 + tn / NT) * 256, (tn % NT) * 128, tn < PG * NT};
    gemm_tile<EPI_OUT, 2>(A, 1024, Bt, 1024, 1024, (g0 + tl / NT) * 256, (tl % NT) * 128, lds, P, layer, tid, ra, rb, pref, nx);
    pref = nx.valid;
  }
}

DEVI void phase_final(int wv, const Params& P) {
  const int tid = otid(wv), wid = tid >> 6, lane = tid & 63;
  const int gw = blockIdx.x * (NTHR / 64) + wid, nw = gridDim.x * (NTHR / 64);
  const int b = gw & 7, i0 = gw >> 3, istep = nw >> 3;
  const size_t ro = (size_t)b * SEQ * 1024;
  float* xo = P.out + ro;
  const bfu* dsrc = reinterpret_cast<const bfu*>(P.ws + O_D) + ro;
  const float* g1v = reinterpret_cast<const float*>(P.ws + O_MOD) + (size_t)9 * 3072 + (size_t)b * 3072 + 2048;
  f32x4 GW[4], G1[4];
#pragma unroll
  for (int i = 0; i < 4; ++i) { GW[i] = *reinterpret_cast<const f32x4*>(P.final_norm_w + (i * 64 + lane) * 4); G1[i] = *reinterpret_cast<const f32x4*>(g1v + (i * 64 + lane) * 4); }
  f32x4 XA[2][4], XB[2][4]; u32x2 DA[2][4], DB[2][4];
#define LOADSET(X, D, IB) do { _Pragma("unroll") for (int q = 0; q < 2; ++q) { const int idx = (IB) + q * istep; if (idx < SEQ) { \
      _Pragma("unroll") for (int i = 0; i < 4; ++i) { X[q][i] = *reinterpret_cast<const f32x4*>(xo + (size_t)idx * 1024 + (i * 64 + lane) * 4); \
        D[q][i] = *reinterpret_cast<const u32x2*>(dsrc + (size_t)idx * 1024 + (i * 64 + lane) * 4); } } } } while (0)
#define PROCSET(X, D, IB) do { _Pragma("unroll") for (int q = 0; q < 2; ++q) { const int idx = (IB) + q * istep; if (idx < SEQ) { \
      float ss = 0.f; \
      _Pragma("unroll") for (int i = 0; i < 4; ++i) { \
        X[q][i][0] += G1[i][0] * bflo(D[q][i][0]); X[q][i][1] += G1[i][1] * bfhi(D[q][i][0]); \
        X[q][i][2] += G1[i][2] * bflo(D[q][i][1]); X[q][i][3] += G1[i][3] * bfhi(D[q][i][1]); \
        ss += X[q][i][0] * X[q][i][0] + X[q][i][1] * X[q][i][1] + X[q][i][2] * X[q][i][2] + X[q][i][3] * X[q][i][3]; } \
      ss = wsum(ss); \
      const float r = rsqrtf(ss * (1.f / 1024.f) + EPS); \
      _Pragma("unroll") for (int i = 0; i < 4; ++i) { \
        f32x4 o = {X[q][i][0] * r * GW[i][0], X[q][i][1] * r * GW[i][1], X[q][i][2] * r * GW[i][2], X[q][i][3] * r * GW[i][3]}; \
        *reinterpret_cast<f32x4*>(xo + (size_t)idx * 1024 + (i * 64 + lane) * 4) = o; } } } } while (0)
  int ib = i0;
  LOADSET(XA, DA, ib);
  while (ib < SEQ) {
    LOADSET(XB, DB, ib + 2 * istep);
    PROCSET(XA, DA, ib);
    ib += 2 * istep; if (ib >= SEQ) break;
    LOADSET(XA, DA, ib + 2 * istep);
    PROCSET(XB, DB, ib);
    ib += 2 * istep;
  }
#undef LOADSET
#undef PROCSET
}

DEVI bool is_t0(int wv) { return wv == 0 && __builtin_amdgcn_mbcnt_hi(~0u, __builtin_amdgcn_mbcnt_lo(~0u, 0u)) == 0u; }
#define XB_TMO      128
#define XB_XCNT(j)  (256  + 64 * (j))
#define XB_XSUB(j)  (1280 + 64 * (j))
#define XB_XGEN(j)  (2304 + 64 * (j))
#define XB_TOP      3328
#define XB_TOPGEN   3392
#define XB_SPIN_CAP (1u << 18)
#define LAS __attribute__((address_space(3)))
DEVI unsigned xb_ld(unsigned* p)              { return __hip_atomic_load(p, __ATOMIC_RELAXED, __HIP_MEMORY_SCOPE_AGENT); }
DEVI unsigned xb_add(unsigned* p, unsigned v) { return __hip_atomic_fetch_add(p, v, __ATOMIC_RELAXED, __HIP_MEMORY_SCOPE_AGENT); }
DEVI unsigned xb_xcc_id() { return (unsigned)__builtin_amdgcn_s_getreg((3 << 11) | 20) & 0xFu; }
#define XB_SPIN(cond, bar) do { unsigned _sp = 0; while (cond) { __builtin_amdgcn_s_sleep(1); \
    if ((++_sp & 255u) == 0u) { if (xb_ld(&(bar)[XB_TMO])) break; if (_sp > XB_SPIN_CAP) { atomicAdd(&(bar)[XB_TMO], 1u); break; } } } } while (0)
DEVI void xcd_barrier_complete(unsigned* bar, unsigned x, unsigned& nloc, unsigned& nx) {
  const unsigned G = gridDim.x * gridDim.y * gridDim.z;
  unsigned sum, cnt, mine, sp = 0u;
  for (;;) {
    sum = 0u; cnt = 0u; mine = 0u;
#pragma unroll
    for (unsigned j = 0; j < 16; ++j) { const unsigned c = xb_ld(&bar[XB_XCNT(j)]); sum += c; cnt += (c > 0u) ? 1u : 0u; mine = (j == x) ? c : mine; }
    if (sum == G) break;
    __builtin_amdgcn_s_sleep(1);
    if ((++sp & 255u) == 0u) { if (xb_ld(&bar[XB_TMO])) break; if (sp > XB_SPIN_CAP) { atomicAdd(&bar[XB_TMO], 1u); break; } }
  }
  nloc = mine > 0u ? mine : 1u; nx = cnt > 0u ? cnt : 1u;
}
DEVI void xcd_barrier(char* ws, char* lds, int wv) {
  asm volatile("s_waitcnt vmcnt(0)" ::: "memory");
  __syncthreads();
  if (is_t0(wv)) {
    unsigned* bar = reinterpret_cast<unsigned*>(ws + O_XBAR);
    volatile LAS unsigned* st = (volatile LAS unsigned*)(unsigned)((unsigned)(uintptr_t)lds + LDS_BYTES);
    const unsigned x = xb_xcc_id();
    __builtin_amdgcn_s_waitcnt(0);
    unsigned nloc = st[0], nx = st[1];
    if (nloc == 0u) { xcd_barrier_complete(bar, x, nloc, nx); st[0] = nloc; st[1] = nx; }
    const unsigned old = xb_add(&bar[XB_XSUB(x)], 1u);
    const unsigned gen = old / nloc;
    if (old + 1u == (gen + 1u) * nloc) {
      __builtin_amdgcn_fence(__ATOMIC_RELEASE, "agent");
      asm volatile("s_waitcnt vmcnt(0)" ::: "memory");
      const unsigned og = xb_add(&bar[XB_TOP], 1u);
      const unsigned tg = og / nx;
      if (og + 1u == (tg + 1u) * nx) xb_add(&bar[XB_TOPGEN], 1u);
      else XB_SPIN(xb_ld(&bar[XB_TOPGEN]) == tg, bar);
      __builtin_amdgcn_fence(__ATOMIC_ACQUIRE, "agent");
      xb_add(&bar[XB_XGEN(x)], 1u);
      asm volatile("s_waitcnt vmcnt(0)" ::: "memory");
    } else {
      XB_SPIN(xb_ld(&bar[XB_XGEN(x)]) == gen, bar);
      __builtin_amdgcn_fence(__ATOMIC_ACQUIRE, "agent");
      asm volatile("s_waitcnt vmcnt(0)" ::: "memory");
    }
  }
  __syncthreads();
}

DEVI void gsync(unsigned* ctr, unsigned gen, int wv) {
  asm volatile("s_waitcnt vmcnt(0)" ::: "memory");
  __syncthreads();
  if (is_t0(wv)) {
    __builtin_amdgcn_fence(__ATOMIC_RELEASE, "agent");
    asm volatile("s_waitcnt vmcnt(0)" ::: "memory");
    __hip_atomic_fetch_add(ctr, 1u, __ATOMIC_RELAXED, __HIP_MEMORY_SCOPE_AGENT);
    const unsigned target = gen * gridDim.x;
    while (__hip_atomic_load(ctr, __ATOMIC_RELAXED, __HIP_MEMORY_SCOPE_AGENT) < target) __builtin_amdgcn_s_sleep(1);
    __builtin_amdgcn_fence(__ATOMIC_ACQUIRE, "agent");
    asm volatile("s_waitcnt vmcnt(0)" ::: "memory");
  }
  __syncthreads();
}

#ifndef PH_MASK
#define PH_MASK 0xff
#endif
#ifndef REP_MASK
#define REP_MASK 0
#endif
__global__ void __launch_bounds__(NTHR) fwd_megakernel(Params P) {
  extern __shared__ __attribute__((aligned(16))) char lds[];
  cg::grid_group grid = cg::this_grid();
  const int wv = __builtin_amdgcn_readfirstlane((int)(threadIdx.x >> 6));
  {
    volatile LAS unsigned* xst = (volatile LAS unsigned*)(unsigned)((unsigned)(uintptr_t)lds + LDS_BYTES);
    if (threadIdx.x == 0) { xst[0] = 0u; xst[1] = 0u; (void)xb_add(reinterpret_cast<unsigned*>(P.ws + O_XBAR) + XB_XCNT(xb_xcc_id()), 1u); }
    __syncthreads();
  }
  if constexpr (PH_MASK & 1) phase_prep(wv, P, lds);
  grid.sync();
#pragma nounroll
  for (int layer = 0; layer < 2; ++layer) {
    const bool last = layer == 1;
    unsigned* bar = reinterpret_cast<unsigned*>(ows(P.ws + O_BAR));
    const unsigned g0 = layer * 6;
    if constexpr (PH_MASK & 2) phase_hnorm(wv, P, layer);
    if constexpr (PH_MASK & 1) { if (layer == 0) phase_wprep(wv, P); }
    xcd_barrier(P.ws, lds, wv);
    if constexpr (PH_MASK & 4) phase_gemm_in(wv, P, layer, last, lds);
    xcd_barrier(P.ws, lds, wv);
    if constexpr (PH_MASK & 8) phase_rows(wv, P, layer, last, lds);
    if constexpr (REP_MASK & 8) { __syncthreads(); phase_rows(wv, P, layer, last, lds); }
    xcd_barrier(P.ws, lds, wv);
    if constexpr (PH_MASK & 16) phase_gemm_mid(wv, P, layer, last, lds);
    if constexpr (REP_MASK & 16) { __syncthreads(); phase_gemm_mid(wv, P, layer, last, lds); }
    xcd_barrier(P.ws, lds, wv);
    unsigned badmask = 0u;
    if constexpr (PH_MASK & 32) badmask = phase_attn<true>(wv, P, last, lds, 0u);
    if (badmask && is_t0(wv)) __hip_atomic_fetch_add(bar + 16 + layer, 1u, __ATOMIC_RELAXED, __HIP_MEMORY_SCOPE_AGENT);
    xcd_barrier(P.ws, lds, wv);
    if (__hip_atomic_load(bar + 16 + layer, __ATOMIC_RELAXED, __HIP_MEMORY_SCOPE_AGENT) != 0u) {
      if constexpr (PH_MASK & 32) phase_attn<false>(wv, P, last, lds, badmask);
      xcd_barrier(P.ws, lds, wv);
    }
    if constexpr (PH_MASK & 64) phase_gemm_out(wv, P, layer, last, lds);
    if constexpr (REP_MASK & 64) { if (!last) { __syncthreads(); phase_gemm_out(wv, P, layer, last, lds); } }
    xcd_barrier(P.ws, lds, wv);
  }
  if constexpr (PH_MASK & 128) phase_final(wv, P);
}

extern "C" void kernel_launch(void* const* d_in, const int* in_sizes, int n_in, void* d_out, int out_size, void* d_ws, size_t ws_size, hipStream_t stream) {
  static int grid_blocks = 0;
  if (!grid_blocks) {
    int dev = 0, cus = 0, per_cu = 0;
    hipGetDevice(&dev);
    hipDeviceGetAttribute(&cus, hipDeviceAttributeMultiprocessorCount, dev);
    hipFuncSetAttribute((const void*)fwd_megakernel, hipFuncAttributeMaxDynamicSharedMemorySize, LDS_BYTES + 16);
    hipOccupancyMaxActiveBlocksPerMultiprocessor(&per_cu, fwd_megakernel, NTHR, LDS_BYTES + 16);
    if (per_cu < 1) { fprintf(stderr, "kernel_launch: occupancy query returned %d\n", per_cu); per_cu = 1; }
    grid_blocks = cus;
    if (ws_size < O_END) fprintf(stderr, "kernel_launch: workspace too small: %zu < %zu\n", ws_size, (size_t)O_END);
  }
  Params p{};
  const float** f = reinterpret_cast<const float**>(&p);
  for (int i = 0; i < 22; ++i) f[i] = static_cast<const float*>(d_in[i]);
  p.out = static_cast<float*>(d_out);
  p.ws = static_cast<char*>(d_ws);
  hipMemsetAsync(p.ws + O_BAR, 0, 256 + 3456 * 4, stream);
  void* args[] = {&p};
  hipError_t e = hipLaunchCooperativeKernel((const void*)fwd_megakernel, dim3(grid_blocks), dim3(NTHR), args, LDS_BYTES + 16, stream);
  if (e != hipSuccess) fprintf(stderr, "cooperative launch failed: %s (grid %d)\n", hipGetErrorString(e), grid_blocks);
}
```

```cpp
#include <hip/hip_runtime.h>
#include <hip/hip_cooperative_groups.h>
#include <cstdio>
#include <cstdint>
namespace cg = cooperative_groups;

#define DEVI __device__ __forceinline__
typedef unsigned short bfu;
typedef __attribute__((ext_vector_type(8))) short bf16x8;
typedef __attribute__((ext_vector_type(4))) short s16x4;
typedef __attribute__((ext_vector_type(16))) float f32x16;
typedef __attribute__((ext_vector_type(4))) float f32x4;
typedef __attribute__((ext_vector_type(4))) unsigned u32x4;
typedef __attribute__((ext_vector_type(2))) unsigned u32x2;

constexpr int NB = 8, SEQ = 4096, DM = 1024, CTX = 256, TK = SEQ + CTX;
constexpr int ML = NB * SEQ, MC = NB * CTX, MT = ML + MC;
constexpr int INC = 2592, INP = 2816;
constexpr int NTHR = 512;
constexpr float EPS = 1e-6f;
constexpr float LOG2E = 1.4426950408889634f;
constexpr float QS_M = 0.10206207261596575f * LOG2E;
constexpr float QS_G = 0.125f * LOG2E;
constexpr int PC_MLAQ = 0, PC_KV = 256, PC_KR = 384, PC_GK = 416, PC_GV = 544, PC_GQ = 672, PC_CONV = 1056, PC_GATE = 1568;

constexpr size_t al256(size_t x) { return (x + 255) / 256 * 256; }
constexpr size_t SZ_WIN = (size_t)INP * 1024 * 2, SZ_WUQ = (size_t)640 * 256 * 2, SZ_WUKV = (size_t)768 * 128 * 2, SZ_WPW = (size_t)256 * 256 * 2,
                 SZ_WOUT = (size_t)1024 * 1024 * 2;
constexpr size_t O_WIN = 0;
constexpr size_t O_WUQ = O_WIN + 2 * SZ_WIN;
constexpr size_t O_WUKV = O_WUQ + 2 * SZ_WUQ;
constexpr size_t O_WPW = O_WUKV + 2 * SZ_WUKV;
constexpr size_t O_WOUT = O_WPW + 2 * SZ_WPW;
constexpr size_t O_MOD = O_WOUT + 2 * SZ_WOUT;
constexpr size_t O_ROPE = O_MOD + al256((size_t)2 * 9 * 3072 * 4);
constexpr size_t O_STATS = O_ROPE + al256((size_t)3072 * 4);
constexpr size_t O_CTX1 = O_STATS + al256((size_t)MT * 2 * 4);
constexpr size_t O_H = O_CTX1 + (size_t)MC * 1024 * 4;
constexpr size_t O_P = O_H + (size_t)MT * 1024 * 2;
constexpr size_t O_QM = O_P + (size_t)MT * INC * 2;
constexpr size_t O_KM = O_QM + (size_t)NB * 6 * TK * 96 * 2;
constexpr size_t O_VM = O_KM + (size_t)NB * 6 * TK * 96 * 2;
constexpr size_t O_QG = O_VM + (size_t)NB * 6 * TK * 64 * 2;
constexpr size_t O_KG = O_QG + (size_t)NB * 6 * TK * 64 * 2;
constexpr size_t O_VG = O_KG + (size_t)NB * 2 * TK * 64 * 2;
constexpr size_t O_Z = O_VG + (size_t)NB * 2 * TK * 64 * 2;
constexpr size_t O_BAR = O_Z + (size_t)MT * 256 * 2;
constexpr size_t O_D = O_QM;
static_assert((size_t)MT * 1024 * 2 <= O_VM - O_QM, "d does not fit");
constexpr size_t O_XBAR = O_BAR + 256;
constexpr size_t O_END = O_XBAR + 3456 * 4;

struct Params {
  const float *x, *c, *ctx, *c_ctx, *norm_w, *w_mod, *b_mod, *w_in, *mla_q_norm, *mla_w_uq, *mla_kv_norm, *mla_w_ukv, *gqa_q_norm, *gqa_k_norm,
      *conv_dw_w, *conv_dw_b, *conv_ln_w, *conv_ln_b, *conv_pw_w, *conv_pw_b, *w_out, *final_norm_w;
  float* out;
  char* ws;
};

DEVI unsigned short f2bf(float f) { unsigned u = __float_as_uint(f); u += 0x7fffu + ((u >> 16) & 1u); return (unsigned short)(u >> 16); }
DEVI float bf2f(unsigned short h) { return __uint_as_float(((unsigned)h) << 16); }
DEVI unsigned pk2(float lo, float hi) { return (unsigned)f2bf(lo) | ((unsigned)f2bf(hi) << 16); }
DEVI unsigned cvtpk(float lo, float hi) { unsigned r; asm volatile("v_cvt_pk_bf16_f32 %0, %1, %2" : "=v"(r) : "v"(lo), "v"(hi)); return r; }
DEVI float bflo(unsigned w) { return __uint_as_float(w << 16); }
DEVI float bfhi(unsigned w) { return __uint_as_float(w & 0xffff0000u); }
DEVI int otid(int wv) { int t = (wv << 6) | (int)__builtin_amdgcn_mbcnt_hi(~0u, __builtin_amdgcn_mbcnt_lo(~0u, 0u)); asm volatile("" : "+v"(t)); return t; }
DEVI int obid() { int t = blockIdx.x; asm volatile("" : "+s"(t)); return t; }
DEVI char* ows(const char* p) { char* q = const_cast<char*>(p); asm volatile("" : "+s"(q)); return q; }
template <int X> DEVI float swz_xor(float v) { return __int_as_float(__builtin_amdgcn_ds_swizzle(__float_as_int(v), (X << 10) | 0x1f)); }
DEVI float wsum(float v) {
  v += swz_xor<1>(v); v += swz_xor<2>(v); v += swz_xor<4>(v); v += swz_xor<8>(v); v += swz_xor<16>(v);
  auto rr = __builtin_amdgcn_permlane32_swap(__float_as_uint(v), __float_as_uint(v), false, false);
  return __uint_as_float(rr[0]) + __uint_as_float(rr[1]);
}
DEVI float siluf(float v) { return v * __builtin_amdgcn_rcpf(1.f + __expf(-v)); }
DEVI int crow(int r, int hi) { return (r & 3) + 8 * (r >> 2) + 4 * hi; }
DEVI f32x16 mfma32(bf16x8 a, bf16x8 b, f32x16 c) { return __builtin_amdgcn_mfma_f32_32x32x16_bf16(a, b, c, 0, 0, 0); }

DEVI void rowinfo(int row, int& b, int& t, int& v) {
  if (row < ML) { b = row >> 12; t = row & 4095; v = b; }
  else { int rc = row - ML; b = rc >> 8; t = SEQ + (rc & 255); v = 8; }
}

DEVI void prep_transpose(const float* __restrict__ src, bfu* __restrict__ dst, int K, int N, int Npad, const float* __restrict__ gk, int gtid, int gthreads) {
  const int items = Npad * (K / 8);
  for (int i = gtid; i < items; i += gthreads) {
    const int n = i % Npad, k8 = i / Npad;
    u32x4 w = {0u, 0u, 0u, 0u};
    if (n < N) {
      float v[8];
#pragma unroll
      for (int j = 0; j < 8; ++j) { float s = src[(size_t)(k8 * 8 + j) * N + n]; if (gk) s *= gk[k8 * 8 + j]; v[j] = s; }
      w[0] = pk2(v[0], v[1]); w[1] = pk2(v[2], v[3]); w[2] = pk2(v[4], v[5]); w[3] = pk2(v[6], v[7]);
    }
    *reinterpret_cast<u32x4*>(dst + (size_t)n * K + k8 * 8) = w;
  }
}

DEVI void sincos_d(double a, float& c, float& s) {
  const double TWO_PI = 6.283185307179586476925286766559;
  double k = rint(a / TWO_PI);
  double r = a - k * TWO_PI;
  double r2 = r * r, ts = r, ss = r, tc = 1.0, cc = 1.0;
#pragma unroll
  for (int n = 1; n <= 14; ++n) {
    ts *= -r2 / (double)((2 * n) * (2 * n + 1)); ss += ts;
    tc *= -r2 / (double)((2 * n - 1) * (2 * n)); cc += tc;
  }
  c = (float)cc; s = (float)ss;
}

DEVI void phase_prep(int wv, const Params& P, char* lds) {
  const int tid = otid(wv), wid = tid >> 6, lane = tid & 63;
  const int gtid = blockIdx.x * NTHR + tid, gthreads = gridDim.x * NTHR;
  float* sc = reinterpret_cast<float*>(lds);
  float* part = sc + 9 * 1024;
  float* mod = reinterpret_cast<float*>(P.ws + O_MOD);
  bool staged = false;
  for (int it = blockIdx.x; it < 96; it += gridDim.x) {
    if (!staged) {
      for (int idx = tid; idx < 9 * 1024; idx += NTHR) {
        int v = idx >> 10, k = idx & 1023;
        float cv = (v < 8) ? P.c[v * 1024 + k] : P.c_ctx[k];
        sc[idx] = siluf(cv);
      }
      staged = true;
    }
    __syncthreads();
    const int l = it / 48, j0 = (it % 48) * 64;
    const float* wm = P.w_mod + (size_t)l * 1024 * 3072 + j0 + lane;
    float acc[9];
#pragma unroll
    for (int v = 0; v < 9; ++v) acc[v] = 0.f;
    for (int k = wid * 128; k < wid * 128 + 128; k += 16) {
      float wv[16];
#pragma unroll
      for (int u = 0; u < 16; ++u) wv[u] = wm[(size_t)(k + u) * 3072];
#pragma unroll
      for (int v = 0; v < 9; ++v) {
        const float* s_ = sc + v * 1024 + k;
        float a_ = 0.f;
#pragma unroll
        for (int u = 0; u < 16; ++u) a_ += s_[u] * wv[u];
        acc[v] += a_;
      }
    }
#pragma unroll
    for (int v = 0; v < 9; ++v) part[(wid * 9 + v) * 64 + lane] = acc[v];
    __syncthreads();
    for (int o = tid; o < 9 * 64; o += NTHR) {
      int v = o >> 6, jl = o & 63;
      float s = P.b_mod[l * 3072 + j0 + jl];
#pragma unroll
      for (int w = 0; w < 8; ++w) s += part[(w * 9 + v) * 64 + jl];
      mod[((size_t)l * 9 + v) * 3072 + j0 + jl] = s;
    }
    __syncthreads();
  }
  if (gtid < 1536) {
    float* rt = reinterpret_cast<float*>(P.ws + O_ROPE);
    int pos, i, half; float* cdst; float* sdst;
    if (gtid < 512) { pos = gtid >> 3; i = gtid & 7; half = 8; cdst = rt + gtid; sdst = rt + 512 + gtid; }
    else { int g = gtid - 512; pos = g >> 4; i = g & 15; half = 16; cdst = rt + 1024 + g; sdst = rt + 2048 + g; }
    float freq = exp2f(-(float)i / (float)half * 13.287712379549449f);
    float ang = (float)pos * freq;
    float c, s; sincos_d((double)ang, c, s);
    *cdst = c; *sdst = s;
  }
}

DEVI void phase_wprep(int wv, const Params& P) {
  const int tid = otid(wv);
  const int gtid = blockIdx.x * NTHR + tid, gthreads = gridDim.x * NTHR;
  for (int l = 0; l < 2; ++l) {
    prep_transpose(P.w_in + (size_t)l * 1024 * INC, reinterpret_cast<bfu*>(P.ws + O_WIN + l * SZ_WIN), 1024, INC, INP, nullptr, gtid, gthreads);
    prep_transpose(P.mla_w_uq + (size_t)l * 256 * 576, reinterpret_cast<bfu*>(P.ws + O_WUQ + l * SZ_WUQ), 256, 576, 640, P.mla_q_norm + l * 256, gtid, gthreads);
    prep_transpose(P.mla_w_ukv + (size_t)l * 128 * 768, reinterpret_cast<bfu*>(P.ws + O_WUKV + l * SZ_WUKV), 128, 768, 768, P.mla_kv_norm + l * 128, gtid, gthreads);
    prep_transpose(P.conv_pw_w + (size_t)l * 256 * 256, reinterpret_cast<bfu*>(P.ws + O_WPW + l * SZ_WPW), 256, 256, 256, nullptr, gtid, gthreads);
    prep_transpose(P.w_out + (size_t)l * 1024 * 1024, reinterpret_cast<bfu*>(P.ws + O_WOUT + l * SZ_WOUT), 1024, 1024, 1024, nullptr, gtid, gthreads);
  }
}

DEVI void hnorm_rows(const float* __restrict__ src, float* __restrict__ xdst, bfu* __restrict__ hdst, const bfu* __restrict__ dsrc,
                     int i0, int istep, int n, const float* __restrict__ modv, const float* __restrict__ g0v, const float* __restrict__ nwp,
                     bool apply_res, int lane) {
  f32x4 A[4], S0[4], G0[4];
#pragma unroll
  for (int i = 0; i < 4; ++i) {
    const int col = (i * 64 + lane) * 4;
    const f32x4 g = *reinterpret_cast<const f32x4*>(nwp + col), s1 = *reinterpret_cast<const f32x4*>(modv + 1024 + col);
    S0[i] = *reinterpret_cast<const f32x4*>(modv + col);
    A[i] = f32x4{g[0] * (1.f + s1[0]), g[1] * (1.f + s1[1]), g[2] * (1.f + s1[2]), g[3] * (1.f + s1[3])};
    G0[i] = apply_res ? *reinterpret_cast<const f32x4*>(g0v + col) : f32x4{0.f, 0.f, 0.f, 0.f};
  }
  f32x4 XA[2][4], XB[2][4]; u32x2 DA[2][4], DB[2][4];
#define LOADSET(X, D, IB) do { _Pragma("unroll") for (int q = 0; q < 2; ++q) { const int idx = (IB) + q * istep; if (idx < n) { \
      _Pragma("unroll") for (int i = 0; i < 4; ++i) X[q][i] = *reinterpret_cast<const f32x4*>(src + (size_t)idx * 1024 + (i * 64 + lane) * 4); \
      if (apply_res) { _Pragma("unroll") for (int i = 0; i < 4; ++i) D[q][i] = *reinterpret_cast<const u32x2*>(dsrc + (size_t)idx * 1024 + (i * 64 + lane) * 4); } } } } while (0)
#define PROCSET(X, D, IB) do { _Pragma("unroll") for (int q = 0; q < 2; ++q) { const int idx = (IB) + q * istep; if (idx < n) { \
      if (apply_res) { _Pragma("unroll") for (int i = 0; i < 4; ++i) { \
          X[q][i][0] += G0[i][0] * bflo(D[q][i][0]); X[q][i][1] += G0[i][1] * bfhi(D[q][i][0]); \
          X[q][i][2] += G0[i][2] * bflo(D[q][i][1]); X[q][i][3] += G0[i][3] * bfhi(D[q][i][1]); \
          *reinterpret_cast<f32x4*>(xdst + (size_t)idx * 1024 + (i * 64 + lane) * 4) = X[q][i]; } } \
      float ss = 0.f; \
      _Pragma("unroll") for (int i = 0; i < 4; ++i) ss += X[q][i][0] * X[q][i][0] + X[q][i][1] * X[q][i][1] + X[q][i][2] * X[q][i][2] + X[q][i][3] * X[q][i][3]; \
      ss = wsum(ss); \
      const float r = rsqrtf(ss * (1.f / 1024.f) + EPS); \
      _Pragma("unroll") for (int i = 0; i < 4; ++i) { \
        const float o0 = X[q][i][0] * r * A[i][0] + S0[i][0], o1 = X[q][i][1] * r * A[i][1] + S0[i][1]; \
        const float o2 = X[q][i][2] * r * A[i][2] + S0[i][2], o3 = X[q][i][3] * r * A[i][3] + S0[i][3]; \
        u32x2 w = {pk2(o0, o1), pk2(o2, o3)}; \
        *reinterpret_cast<u32x2*>(hdst + (size_t)idx * 1024 + (i * 64 + lane) * 4) = w; } } } } while (0)
  int ib = i0;
  LOADSET(XA, DA, ib);
  while (ib < n) {
    LOADSET(XB, DB, ib + 2 * istep);
    PROCSET(XA, DA, ib);
    ib += 2 * istep; if (ib >= n) break;
    LOADSET(XA, DA, ib + 2 * istep);
    PROCSET(XB, DB, ib);
    ib += 2 * istep;
  }
#undef LOADSET
#undef PROCSET
}

DEVI void phase_hnorm(int wv, const Params& P, int layer) {
  const int tid = otid(wv), wid = tid >> 6, lane = tid & 63;
  const int gw = blockIdx.x * (NTHR / 64) + wid, nw = gridDim.x * (NTHR / 64);
  const float* mod = reinterpret_cast<const float*>(P.ws + O_MOD) + (size_t)layer * 9 * 3072;
  const float* mod0 = reinterpret_cast<const float*>(P.ws + O_MOD);
  const float* nwp = P.norm_w + layer * 1024;
  bfu* hb = reinterpret_cast<bfu*>(P.ws + O_H);
  const bfu* dbuf = reinterpret_cast<const bfu*>(P.ws + O_D);
  const bool res = layer == 1;
  {
    const int b = gw & 7;
    const size_t ro = (size_t)b * SEQ * 1024;
    hnorm_rows(P.x + ro, P.out + ro, hb + ro, dbuf + ro, gw >> 3, nw >> 3, SEQ, mod + (size_t)b * 3072, mod0 + (size_t)b * 3072 + 2048, nwp, res, lane);
  }
  {
    const size_t ro = (size_t)ML * 1024;
    hnorm_rows(P.ctx, reinterpret_cast<float*>(P.ws + O_CTX1), hb + ro, dbuf + ro, gw, nw, MC, mod + (size_t)8 * 3072, mod0 + (size_t)8 * 3072 + 2048, nwp, res, lane);
  }
}

constexpr int GROW = 144;
constexpr int G_A_BYTES = 256 * GROW;
constexpr int g_stage(int wn) { return G_A_BYTES + 64 * wn * GROW; }
constexpr int LDS_BYTES = 2 * g_stage(4);
enum { EPI_P = 0, EPI_Q = 1, EPI_KV = 2, EPI_CONV = 3, EPI_OUT = 4 };

struct NextTile { const bfu* A; const bfu* Bt; int lda, ldb, m0, n0; bool valid; };
template <int EPI, int WN>
DEVI void gemm_tile(const bfu* __restrict__ A, int lda, const bfu* __restrict__ Bt, int ldb, int K, int m0, int n0, char* lds, const Params& P, int layer, int tid,
                    u32x4 (&ra)[4], u32x4 (&rb)[WN], bool have_pref, const NextTile& nx) {
  const int wid = tid >> 6, lane = tid & 63, r32 = lane & 31, hi = lane >> 5;
  constexpr int MI = WN, G_STAGE = g_stage(WN);
  const int wm = wid / WN, wn = wid % WN;
  const int srow = tid >> 3, sch = tid & 7;
  const bfu* Ag = A + (size_t)(m0 + srow) * lda + sch * 8;
  const bfu* Bg = Bt + (size_t)(n0 + srow) * ldb + sch * 8;
  f32x16 acc[MI][2];
#pragma unroll
  for (int i = 0; i < MI; ++i)
#pragma unroll
    for (int j = 0; j < 2; ++j)
#pragma unroll
      for (int r = 0; r < 16; ++r) acc[i][j][r] = 0.f;
  const int nk = K / 64;
#define GLOAD(k0) do { _Pragma("unroll") for (int i = 0; i < 4; ++i) ra[i] = *reinterpret_cast<const u32x4*>(Ag + (size_t)(64 * i) * lda + (k0)); \
    _Pragma("unroll") for (int i = 0; i < WN; ++i) rb[i] = *reinterpret_cast<const u32x4*>(Bg + (size_t)(64 * i) * ldb + (k0)); } while (0)
#define LWRITE(buf) do { char* a_ = lds + (buf) * G_STAGE; _Pragma("unroll") for (int i = 0; i < 4; ++i) *reinterpret_cast<u32x4*>(a_ + (srow + 64 * i) * GROW + sch * 16) = ra[i]; \
    char* b_ = a_ + G_A_BYTES; _Pragma("unroll") for (int i = 0; i < WN; ++i) *reinterpret_cast<u32x4*>(b_ + (srow + 64 * i) * GROW + sch * 16) = rb[i]; } while (0)
#define LDFR(kk, B0, B1, AF) do { B0 = *reinterpret_cast<const bf16x8*>(fb + (kk) * 32); B1 = *reinterpret_cast<const bf16x8*>(fb + 32 * GROW + (kk) * 32); \
    _Pragma("unroll") for (int mi = 0; mi < MI; ++mi) AF[mi] = *reinterpret_cast<const bf16x8*>(fa + mi * 32 * GROW + (kk) * 32); } while (0)
#define MM(B0, B1, AF) do { _Pragma("unroll") for (int mi = 0; mi < MI; ++mi) { acc[mi][0] = mfma32(AF[mi], B0, acc[mi][0]); acc[mi][1] = mfma32(AF[mi], B1, acc[mi][1]); } } while (0)
  bf16x8 b0x, b1x, afx[MI], b0y, b1y, afy[MI];
#define PIECE_A(i) do { if (kt + 1 < nk) *reinterpret_cast<u32x4*>(wbase + (srow + 64 * (i)) * GROW + sch * 16) = ra[i]; \
    if (kt + 2 < nk) ra[i] = *reinterpret_cast<const u32x4*>(Ag + (size_t)(64 * (i)) * lda + (kt + 2) * 64); } while (0)
#define PIECE_B(i) do { if (kt + 1 < nk) *reinterpret_cast<u32x4*>(wbase + G_A_BYTES + (srow + 64 * (i)) * GROW + sch * 16) = rb[i]; \
    if (kt + 2 < nk) rb[i] = *reinterpret_cast<const u32x4*>(Bg + (size_t)(64 * (i)) * ldb + (kt + 2) * 64); } while (0)
#define SB_() __builtin_amdgcn_sched_barrier(0)
  if (have_pref) {
#pragma unroll
    for (int i = 0; i < WN; ++i) rb[i] = *reinterpret_cast<const u32x4*>(Bg + (size_t)(64 * i) * ldb);
  } else GLOAD(0);
  LWRITE(0);
  if (1 < nk) GLOAD(64);
  __syncthreads();
  for (int kt = 0; kt < nk; ++kt) {
    const char* fa = lds + (kt & 1) * G_STAGE + (wm * (MI * 32) + r32) * GROW + hi * 16;
    const char* fb = lds + (kt & 1) * G_STAGE + G_A_BYTES + (wn * 64 + r32) * GROW + hi * 16;
    char* wbase = lds + ((kt + 1) & 1) * G_STAGE;
    LDFR(0, b0x, b1x, afx);
    LDFR(1, b0y, b1y, afy);
    SB_(); MM(b0x, b1x, afx); SB_();
    PIECE_A(0); PIECE_A(1);
    LDFR(2, b0x, b1x, afx);
    SB_(); MM(b0y, b1y, afy); SB_();
    PIECE_A(2); PIECE_A(3);
    LDFR(3, b0y, b1y, afy);
    SB_(); MM(b0x, b1x, afx); SB_();
    PIECE_B(0); if constexpr (WN == 4) PIECE_B(1);
    SB_(); MM(b0y, b1y, afy); SB_();
    if constexpr (WN == 4) { PIECE_B(2); PIECE_B(3); } else { PIECE_B(1); }
    __syncthreads();
  }
  if (nx.valid) {
    const bfu* An_ = nx.A + (size_t)(nx.m0 + srow) * nx.lda + sch * 8;
#pragma unroll
    for (int i = 0; i < 4; ++i) ra[i] = *reinterpret_cast<const u32x4*>(An_ + (size_t)(64 * i) * nx.lda);
  }
#undef PIECE_A
#undef PIECE_B
#undef SB_
#undef GLOAD
#undef LWRITE
#undef LDFR
#undef MM
  const bool latent = m0 < ML;
  const int tb_b = latent ? (m0 >> 12) : ((m0 - ML) >> 8), tb_t = latent ? (m0 & 4095) : SEQ;
  bfu* pbuf = reinterpret_cast<bfu*>(P.ws + O_P);
  const float* stats = reinterpret_cast<const float*>(P.ws + O_STATS);
  {
    char* reg = lds + G_STAGE + wid * (32 * GROW);
    const float* rt = reinterpret_cast<const float*>(P.ws + O_ROPE);
    const int cw0 = n0 + wn * 64;
    float cbias[2] = {0.f, 0.f};
    if constexpr (EPI == EPI_CONV) { cbias[0] = P.conv_pw_b[layer * 256 + cw0 + r32]; cbias[1] = P.conv_pw_b[layer * 256 + cw0 + 32 + r32]; }
#pragma unroll
    for (int mi = 0; mi < MI; ++mi) {
      float st[16];
      if constexpr (EPI == EPI_Q || EPI == EPI_KV) {
#pragma unroll
        for (int r = 0; r < 16; ++r) st[r] = stats[(m0 + wm * (MI * 32) + mi * 32 + crow(r, hi)) * 2 + (EPI == EPI_KV ? 1 : 0)];
      }
#pragma unroll
      for (int ni = 0; ni < 2; ++ni) {
        const int nb = cw0 + ni * 32;
        bool rope = false;
        if constexpr (EPI == EPI_Q) rope = latent && ((nb % 96) / 32 == 2) && (nb < 576);
        float cs[16], sn[16];
        if constexpr (EPI == EPI_Q) {
          if (rope) {
            const int sec = r32 >> 4, fi = r32 & 7;
#pragma unroll
            for (int r = 0; r < 16; ++r) {
              const int t = tb_t + wm * (MI * 32) + mi * 32 + crow(r, hi); const int pos = sec ? (t & 63) : (t >> 6);
              cs[r] = rt[pos * 8 + fi]; sn[r] = rt[512 + pos * 8 + fi];
            }
          }
        }
#pragma unroll
        for (int r = 0; r < 16; ++r) {
          float v = acc[mi][ni][r];
          if constexpr (EPI == EPI_Q || EPI == EPI_KV) v *= st[r];
          if constexpr (EPI == EPI_CONV) v += cbias[ni];
          if constexpr (EPI == EPI_Q) {
            if (rope) { const float pn = swz_xor<8>(v); v = !(r32 & 8) ? (v * cs[r] - pn * sn[r]) : (pn * sn[r] + v * cs[r]); }
            v *= QS_M;
          }
          *reinterpret_cast<bfu*>(reg + crow(r, hi) * GROW + (ni * 32 + r32) * 2) = f2bf(v);
        }
      }
#pragma unroll
      for (int i = 0; i < 4; ++i) {
        const int q_ = lane + 64 * i, rr = q_ >> 3, ch = q_ & 7;
        const u32x4 w = *reinterpret_cast<const u32x4*>(reg + rr * GROW + ch * 16);
        const int lr = wm * (MI * 32) + mi * 32 + rr, colc = cw0 + ch * 8;
        if constexpr (EPI == EPI_P) {
          if (colc < INC) *reinterpret_cast<u32x4*>(pbuf + (size_t)(m0 + lr) * INC + colc) = w;
        } else if constexpr (EPI == EPI_Q) {
          if (colc < 576) { const int h = colc / 96, d = colc % 96;
            *reinterpret_cast<u32x4*>(reinterpret_cast<bfu*>(P.ws + O_QM) + ((size_t)(tb_b * 6 + h) * TK + tb_t + lr) * 96 + d) = w; }
        } else if constexpr (EPI == EPI_OUT) {
          *reinterpret_cast<u32x4*>(reinterpret_cast<bfu*>(P.ws + O_D) + (size_t)(m0 + lr) * 1024 + colc) = w;
        } else if constexpr (EPI == EPI_CONV) {
          const u32x4 gw = *reinterpret_cast<const u32x4*>(pbuf + (size_t)(m0 + lr) * INC + PC_GATE + 768 + colc);
          u32x4 o;
#pragma unroll
          for (int j = 0; j < 4; ++j) o[j] = pk2(bflo(w[j]) * siluf(bflo(gw[j])), bfhi(w[j]) * siluf(bfhi(gw[j])));
          *reinterpret_cast<u32x4*>(reinterpret_cast<bfu*>(P.ws + O_H) + (size_t)(m0 + lr) * 1024 + 768 + colc) = o;
        } else {
          const int h = colc >> 7, e = colc & 127;
          bfu* dst = (e < 64) ? reinterpret_cast<bfu*>(P.ws + O_KM) + ((size_t)(tb_b * 6 + h) * TK + tb_t + lr) * 96 + e
                              : reinterpret_cast<bfu*>(P.ws + O_VM) + ((size_t)(tb_b * 6 + h) * TK + tb_t + lr) * 64 + (e - 64);
          *reinterpret_cast<u32x4*>(dst) = w;
        }
      }
    }
  }
}

DEVI void blk_group(int& grp, int& loc, int& per, int& ngrp) {
  const int nb = gridDim.x;
  if ((nb & 7) == 0) { grp = blockIdx.x & 7; loc = blockIdx.x >> 3; per = nb >> 3; ngrp = 8; }
  else { grp = 0; loc = blockIdx.x; per = nb; ngrp = 1; }
}

DEVI void phase_gemm_in(int wv, const Params& P, int layer, bool last, char* lds) {
  const int tid = otid(wv);
  const bfu* A = reinterpret_cast<const bfu*>(P.ws + O_H);
  const bfu* Bt = reinterpret_cast<const bfu*>(P.ws + O_WIN + layer * SZ_WIN);
  constexpr int PANELS = MT / 256, NT = INP / 256;
  int grp, loc, per, ngrp; blk_group(grp, loc, per, ngrp);
  const int PG = PANELS / ngrp, g0 = grp * PG;
  const NextTile none{nullptr, nullptr, 0, 0, 0, 0, false};
  for (int tl = loc; tl < PG * NT; tl += per) {
    const int pm = g0 + tl / NT, pn = tl % NT;
    if (last && pm * 256 >= ML && (pn < 1 || pn > 2)) continue;
    u32x4 ra[4], rb[4];
    gemm_tile<EPI_P, 4>(A, 1024, Bt, 1024, 1024, pm * 256, pn * 256, lds, P, layer, tid, ra, rb, false, none);
  }
}

DEVI void phase_rows(int wv, const Params& P, int layer, bool last, char* lds) {
  const int tid = otid(wv), wid = tid >> 6, lane = tid & 63;
  const int gw = blockIdx.x * (NTHR / 64) + wid, nw = gridDim.x * (NTHR / 64);
  const bfu* pbuf = reinterpret_cast<const bfu*>(P.ws + O_P);
  float* stats = reinterpret_cast<float*>(P.ws + O_STATS);
  const float* rt = reinterpret_cast<const float*>(P.ws + O_ROPE);
  bfu* Km = reinterpret_cast<bfu*>(P.ws + O_KM);
  bfu* Qg = reinterpret_cast<bfu*>(P.ws + O_QG);
  bfu* Kg = reinterpret_cast<bfu*>(P.ws + O_KG);
  bfu* Vg = reinterpret_cast<bfu*>(P.ws + O_VG);
  const float gq = P.gqa_q_norm[layer * 64 + lane], gk = P.gqa_k_norm[layer * 64 + lane];
  for (int row0 = gw; row0 < MT; row0 += 4 * nw) {
    u32x2 wq[4]; unsigned wkv[4]; bfu xq[4][6], xk[4][2], xvv[4][2], xkr[4]; float csg[4], sng[4], c2m[4], s2m[4];
#pragma unroll
    for (int q = 0; q < 4; ++q) {
      const int row = row0 + q * nw;
      if (row < MT) {
        int b, t, v; rowinfo(row, b, t, v);
        const bfu* pr = pbuf + (size_t)row * INC;
        wq[q] = *reinterpret_cast<const u32x2*>(pr + PC_MLAQ + lane * 4);
        wkv[q] = *reinterpret_cast<const unsigned*>(pr + PC_KV + lane * 2);
#pragma unroll
        for (int h = 0; h < 6; ++h) xq[q][h] = pr[PC_GQ + h * 64 + lane];
#pragma unroll
        for (int g = 0; g < 2; ++g) { xk[q][g] = pr[PC_GK + g * 64 + lane]; xvv[q][g] = pr[PC_GV + g * 64 + lane]; }
        xkr[q] = pr[PC_KR + (lane & 31)];
        csg[q] = 1.f; sng[q] = 0.f; c2m[q] = 1.f; s2m[q] = 0.f;
        if (row < ML) {
          { const int sec = lane >> 5, i = lane & 15; const int pos = sec ? (t & 63) : (t >> 6); csg[q] = rt[1024 + pos * 16 + i]; sng[q] = rt[2048 + pos * 16 + i]; }
          { const int e = lane & 31; const int sec = (e >> 4) & 1, i = e & 7; const int pos = sec ? (t & 63) : (t >> 6); c2m[q] = rt[pos * 8 + i]; s2m[q] = rt[512 + pos * 8 + i]; }
        }
      }
    }
#pragma unroll
    for (int q = 0; q < 4; ++q) {
      const int row = row0 + q * nw;
      if (row < MT) {
        int b, t, v; rowinfo(row, b, t, v);
        const bool latent = row < ML;
        {
          float a0 = bflo(wq[q][0]), a1 = bfhi(wq[q][0]), a2 = bflo(wq[q][1]), a3 = bfhi(wq[q][1]);
          float sq = wsum(a0 * a0 + a1 * a1 + a2 * a2 + a3 * a3);
          float c0 = bflo(wkv[q]), c1 = bfhi(wkv[q]);
          float sk = wsum(c0 * c0 + c1 * c1);
          if (lane == 0) { stats[row * 2] = rsqrtf(sq * (1.f / 256.f) + EPS); stats[row * 2 + 1] = rsqrtf(sk * (1.f / 128.f) + EPS); }
        }
        const float cs = csg[q], sn = sng[q];
        const bool firstg = !(lane & 16);
        if (latent || !last) {
#pragma unroll
          for (int h = 0; h < 6; ++h) {
            float x = bf2f(xq[q][h]);
            float ss = wsum(x * x);
            float xn = x * rsqrtf(ss * (1.f / 64.f) + EPS) * gq;
            float pn = swz_xor<16>(xn);
            float o = firstg ? (xn * cs - pn * sn) : (pn * sn + xn * cs);
            Qg[((size_t)(b * 6 + h) * TK + t) * 64 + lane] = f2bf(o * QS_G);
          }
        }
#pragma unroll
        for (int g = 0; g < 2; ++g) {
          float x = bf2f(xk[q][g]);
          float ss = wsum(x * x);
          float xn = x * rsqrtf(ss * (1.f / 64.f) + EPS) * gk;
          float pn = swz_xor<16>(xn);
          float o = firstg ? (xn * cs - pn * sn) : (pn * sn + xn * cs);
          Kg[((size_t)(b * 2 + g) * TK + t) * 64 + lane] = f2bf(o);
          Vg[((size_t)(b * 2 + g) * TK + t) * 64 + lane] = xvv[q][g];
        }
        {
          const int e = lane & 31;
          float x = bf2f(xkr[q]);
          float pn = swz_xor<8>(x);
          float o = !(e & 8) ? (x * c2m[q] - pn * s2m[q]) : (pn * s2m[q] + x * c2m[q]);
          const bfu ob = f2bf(o);
          const int hb = lane >> 5;
#pragma unroll
          for (int hh = 0; hh < 3; ++hh) Km[((size_t)(b * 6 + hh * 2 + hb) * TK + t) * 96 + 64 + e] = ob;
        }
      }
    }
  }
  float* yb = reinterpret_cast<float*>(lds);
  float* ob = yb + 62 * 256;
  bfu* z = reinterpret_cast<bfu*>(P.ws + O_Z);
  const int ntl = NB * 128, ntc = last ? 0 : NB * 8;
  const int c = tid & 255, hf = tid >> 8;
  for (int tile = blockIdx.x; tile < ntl + ntc; tile += gridDim.x) {
    int rowbase, seqlen, t0;
    if (tile < ntl) { const int b = tile >> 7; rowbase = b * SEQ; seqlen = SEQ; t0 = (tile & 127) * 32; }
    else { const int tt = tile - ntl; const int b = tt >> 3; rowbase = ML + b * CTX; seqlen = CTX; t0 = (tt & 7) * 32; }
    __syncthreads();
    for (int idx = tid; idx < 62 * 32; idx += NTHR) {
      const int tr = idx >> 5, ch = idx & 31, tt = t0 - 15 + tr;
      f32x4 o0 = {0.f, 0.f, 0.f, 0.f}, o1 = {0.f, 0.f, 0.f, 0.f};
      if (tt >= 0 && tt < seqlen) {
        const bfu* pr = pbuf + (size_t)(rowbase + tt) * INC + PC_CONV + ch * 8;
        u32x4 a = *reinterpret_cast<const u32x4*>(pr), g = *reinterpret_cast<const u32x4*>(pr + 256);
#pragma unroll
        for (int j = 0; j < 4; ++j) {
          float al = bflo(a[j]), ah = bfhi(a[j]), gl = bflo(g[j]), gh = bfhi(g[j]);
          float yl = al * __builtin_amdgcn_rcpf(1.f + __expf(-gl)), yh = ah * __builtin_amdgcn_rcpf(1.f + __expf(-gh));
          if (j < 2) { o0[j * 2] = yl; o0[j * 2 + 1] = yh; } else { o1[(j - 2) * 2] = yl; o1[(j - 2) * 2 + 1] = yh; }
        }
      }
      *reinterpret_cast<f32x4*>(yb + tr * 256 + ch * 8) = o0;
      *reinterpret_cast<f32x4*>(yb + tr * 256 + ch * 8 + 4) = o1;
    }
    __syncthreads();
    {
      float acc[16];
      const float bias = P.conv_dw_b[layer * 256 + c];
#pragma unroll
      for (int i = 0; i < 16; ++i) acc[i] = bias;
      const float* wp = P.conv_dw_w + (size_t)layer * 31 * 256 + c;
      const float* yp = yb + (hf * 16) * 256 + c;
#pragma unroll
      for (int j = 0; j < 46; ++j) {
        const float yv = yp[j * 256];
#pragma unroll
        for (int i = 0; i < 16; ++i) {
          const int tap = j - i;
          if (tap >= 0 && tap < 31) acc[i] += wp[tap * 256] * yv;
        }
      }
#pragma unroll
      for (int i = 0; i < 16; ++i) ob[(hf * 16 + i) * 256 + c] = acc[i];
    }
    __syncthreads();
    {
      const f32x4 lw = *reinterpret_cast<const f32x4*>(P.conv_ln_w + layer * 256 + lane * 4);
      const f32x4 lb = *reinterpret_cast<const f32x4*>(P.conv_ln_b + layer * 256 + lane * 4);
#pragma unroll
      for (int q = 0; q < 4; ++q) {
        const int tok = wid * 4 + q;
        f32x4 v = *reinterpret_cast<const f32x4*>(ob + tok * 256 + lane * 4);
        const float mu = wsum(v[0] + v[1] + v[2] + v[3]) * (1.f / 256.f);
        const float d0 = v[0] - mu, d1 = v[1] - mu, d2 = v[2] - mu, d3 = v[3] - mu;
        const float var = wsum(d0 * d0 + d1 * d1 + d2 * d2 + d3 * d3) * (1.f / 256.f);
        const float rs = rsqrtf(var + EPS);
        const float n0 = siluf(d0 * rs * lw[0] + lb[0]), n1 = siluf(d1 * rs * lw[1] + lb[1]), n2 = siluf(d2 * rs * lw[2] + lb[2]), n3 = siluf(d3 * rs * lw[3] + lb[3]);
        u32x2 w = {pk2(n0, n1), pk2(n2, n3)};
        *reinterpret_cast<u32x2*>(z + (size_t)(rowbase + t0 + tok) * 256 + lane * 4) = w;
      }
    }
  }
  __syncthreads();
}

DEVI void phase_gemm_mid(int wv, const Params& P, int layer, bool last, char* lds) {
  const int tid = otid(wv);
  const bfu* pbuf = reinterpret_cast<const bfu*>(P.ws + O_P);
  const bfu* Wuq = reinterpret_cast<const bfu*>(P.ws + O_WUQ + layer * SZ_WUQ);
  const bfu* Wukv = reinterpret_cast<const bfu*>(P.ws + O_WUKV + layer * SZ_WUKV);
  const bfu* Wpw = reinterpret_cast<const bfu*>(P.ws + O_WPW + layer * SZ_WPW);
  const bfu* z = reinterpret_cast<const bfu*>(P.ws + O_Z);
  constexpr int PANELS = MT / 256, SUB = 13;
  int grp, loc, per, ngrp; blk_group(grp, loc, per, ngrp);
  const int PG = PANELS / ngrp, g0 = grp * PG;
  const NextTile none{nullptr, nullptr, 0, 0, 0, 0, false};
  for (int tl = loc; tl < PG * SUB; tl += per) {
    const int pm = g0 + tl / SUB, sub = tl % SUB, m0 = pm * 256;
    const bool ctxp = m0 >= ML;
    u32x4 ra[4], rb[2];
    if (sub < 5) { if (!(last && ctxp)) gemm_tile<EPI_Q, 2>(pbuf + PC_MLAQ, INC, Wuq, 256, 256, m0, sub * 128, lds, P, layer, tid, ra, rb, false, none); }
    else if (sub < 11) gemm_tile<EPI_KV, 2>(pbuf + PC_KV, INC, Wukv, 128, 128, m0, (sub - 5) * 128, lds, P, layer, tid, ra, rb, false, none);
    else { if (!(last && ctxp)) gemm_tile<EPI_CONV, 2>(z, 256, Wpw, 256, 256, m0, (sub - 11) * 128, lds, P, layer, tid, ra, rb, false, none); }
  }
}

DEVI int v_st(int k, int c) { return ((k >> 3) * 2 + (c >> 5)) * 512 + ((k & 7) * 32 + (c & 31)) * 2; }
DEVI int v_rd_base(int lane) { return ((lane & 3) << 3) | (((lane >> 2) & 3) << 6) | (((lane >> 4) & 1) << 5) | (((lane >> 5) & 1) << 8); }
constexpr int v_rd_off(int d0, int ks, int half) { return d0 * 512 + ks * 2048 + half * 1024; }
template <int OFF> DEVI s16x4 tr_read(int vb) {
  s16x4 r; asm volatile("ds_read_b64_tr_b16 %0, %1 offset:%2" : "=&v"(r) : "v"(vb), "i"(OFF) : "memory"); return r;
}
#define SBAR() __builtin_amdgcn_sched_barrier(0)

DEVI void pv_all(f32x16& oa, f32x16& ob, int vb, bf16x8 pa0, bf16x8 pa1, bf16x8 pa2, bf16x8 pa3) {
#define PK(L, H) (bf16x8){L[0], L[1], L[2], L[3], H[0], H[1], H[2], H[3]}
  const s16x4 a0 = tr_read<v_rd_off(0, 0, 0)>(vb), b0 = tr_read<v_rd_off(0, 0, 1)>(vb), c0 = tr_read<v_rd_off(1, 0, 0)>(vb), d0 = tr_read<v_rd_off(1, 0, 1)>(vb);
  const s16x4 a1 = tr_read<v_rd_off(0, 1, 0)>(vb), b1 = tr_read<v_rd_off(0, 1, 1)>(vb), c1 = tr_read<v_rd_off(1, 1, 0)>(vb), d1 = tr_read<v_rd_off(1, 1, 1)>(vb);
  const s16x4 a2 = tr_read<v_rd_off(0, 2, 0)>(vb), b2 = tr_read<v_rd_off(0, 2, 1)>(vb), c2 = tr_read<v_rd_off(1, 2, 0)>(vb), d2 = tr_read<v_rd_off(1, 2, 1)>(vb);
  const s16x4 a3 = tr_read<v_rd_off(0, 3, 0)>(vb), b3 = tr_read<v_rd_off(0, 3, 1)>(vb), c3 = tr_read<v_rd_off(1, 3, 0)>(vb), d3 = tr_read<v_rd_off(1, 3, 1)>(vb);
  asm volatile("s_waitcnt lgkmcnt(0)" ::: "memory"); SBAR();
  oa = mfma32(PK(a0, b0), pa0, oa); ob = mfma32(PK(c0, d0), pa0, ob);
  oa = mfma32(PK(a1, b1), pa1, oa); ob = mfma32(PK(c1, d1), pa1, ob);
  oa = mfma32(PK(a2, b2), pa2, oa); ob = mfma32(PK(c2, d2), pa2, ob);
  oa = mfma32(PK(a3, b3), pa3, oa); ob = mfma32(PK(c3, d3), pa3, ob);
#undef PK
}

template <bool FAST> DEVI void partialSM(f32x16& p0, f32x16& p1, float& m_reg, float& alpha) {
  if constexpr (FAST) { alpha = 1.f; return; }
  float pmax = p0[0];
#pragma unroll
  for (int r = 1; r < 16; ++r) pmax = fmaxf(pmax, p0[r]);
#pragma unroll
  for (int r = 0; r < 16; ++r) pmax = fmaxf(pmax, p1[r]);
  { auto rr = __builtin_amdgcn_permlane32_swap(__float_as_uint(pmax), __float_as_uint(pmax), false, false);
    pmax = fmaxf(__uint_as_float(rr[0]), __uint_as_float(rr[1])); }
  if (__all(pmax <= m_reg)) { alpha = 1.f; }
  else { const float mn = fmaxf(m_reg, pmax); alpha = __builtin_amdgcn_exp2f(m_reg - mn); m_reg = mn; }
#pragma unroll
  for (int r = 0; r < 16; ++r) p0[r] = __builtin_amdgcn_exp2f(p0[r] - m_reg);
#pragma unroll
  for (int r = 0; r < 16; ++r) p1[r] = p1[r] - m_reg;
}
template <bool FAST> DEVI void finishSM(f32x16& p0, f32x16& p1, float alpha, float& l_reg, bf16x8& pa0, bf16x8& pa1, bf16x8& pa2, bf16x8& pa3) {
  if constexpr (FAST) {
#pragma unroll
    for (int r = 0; r < 16; ++r) p0[r] = __builtin_amdgcn_exp2f(p0[r]);
  }
#pragma unroll
  for (int r = 0; r < 16; ++r) p1[r] = __builtin_amdgcn_exp2f(p1[r]);
  float ps = 0.f;
#pragma unroll
  for (int r = 0; r < 16; ++r) ps += p0[r];
#pragma unroll
  for (int r = 0; r < 16; ++r) ps += p1[r];
  if constexpr (FAST) { l_reg += ps; }
  else {
  { auto rr = __builtin_amdgcn_permlane32_swap(__float_as_uint(ps), __float_as_uint(ps), false, false);
    ps = __uint_as_float(rr[0]) + __uint_as_float(rr[1]); }
  l_reg = l_reg * alpha + ps;
  }
#define PK8(P, BASE, OUT) do { u32x4 w = {cvtpk(P[BASE + 0], P[BASE + 1]), cvtpk(P[BASE + 2], P[BASE + 3]), cvtpk(P[BASE + 4], P[BASE + 5]), cvtpk(P[BASE + 6], P[BASE + 7])}; \
    OUT = *reinterpret_cast<bf16x8*>(&w); } while (0)
  PK8(p0, 0, pa0); PK8(p0, 8, pa1); PK8(p1, 0, pa2); PK8(p1, 8, pa3);
#undef PK8
}

template <int DQK>
DEVI void qkt(f32x16& p0, f32x16& p1, const char* Ks, const bf16x8* qr, int r32, int hi) {
  constexpr int KROW = DQK * 2 + 16, ND = DQK / 16;
#pragma unroll
  for (int r = 0; r < 16; ++r) { p0[r] = 0.f; p1[r] = 0.f; }
  const char* ka = Ks + r32 * KROW + hi * 16;
  const char* kb = Ks + (32 + r32) * KROW + hi * 16;
  bf16x8 x0 = *reinterpret_cast<const bf16x8*>(ka), x1 = *reinterpret_cast<const bf16x8*>(kb), y0, y1;
#pragma unroll
  for (int d0 = 0; d0 < ND; d0 += 2) {
    if (d0 + 1 < ND) { y0 = *reinterpret_cast<const bf16x8*>(ka + (d0 + 1) * 32); y1 = *reinterpret_cast<const bf16x8*>(kb + (d0 + 1) * 32); }
    SBAR();
    p0 = mfma32(x0, qr[d0], p0); p1 = mfma32(x1, qr[d0], p1);
    SBAR();
    if (d0 + 1 < ND) {
      if (d0 + 2 < ND) { x0 = *reinterpret_cast<const bf16x8*>(ka + (d0 + 2) * 32); x1 = *reinterpret_cast<const bf16x8*>(kb + (d0 + 2) * 32); }
      SBAR();
      p0 = mfma32(y0, qr[d0 + 1], p0); p1 = mfma32(y1, qr[d0 + 1], p1);
      SBAR();
    }
  }
}

template <int DQK, bool FAST>
DEVI bool attn_unit(const bfu* __restrict__ Q, const bfu* __restrict__ Kh, const bfu* __restrict__ Vh, int nkeys,
                    const bfu* __restrict__ pg, bfu* __restrict__ yo, char* lds, int tid) {
  constexpr int KROW = DQK * 2 + 16, KT_BYTES = 64 * KROW, VT_BYTES = 8192, KCH = 64 * (DQK / 8);
  constexpr int CPR = DQK / 8;
  const int wid = tid >> 6, lane = tid & 63, r32 = lane & 31, hi = lane >> 5;
  char* K_lds = lds; char* V_lds = lds + 3 * KT_BYTES;
  float m_reg = -1e30f, l_reg = 0.f;
  f32x16 o0, o1;
#pragma unroll
  for (int r = 0; r < 16; ++r) { o0[r] = 0.f; o1[r] = 0.f; }
  bf16x8 qr[DQK / 16];
  {
    const bfu* Qw = Q + (size_t)(wid * 32 + r32) * DQK + hi * 8;
#pragma unroll
    for (int d0 = 0; d0 < DQK / 16; ++d0) qr[d0] = *reinterpret_cast<const bf16x8*>(Qw + d0 * 16);
  }
  const bool k2 = (tid + 512) < KCH;
  const int kq0 = tid, kq1 = tid + 512;
  const int kst0 = (kq0 / CPR) * KROW + (kq0 % CPR) * 16, kst1 = (kq1 / CPR) * KROW + (kq1 % CPR) * 16;
  const int vst = v_st(tid >> 3, (tid & 7) * 8);
  const int vb0 = (int)(uintptr_t)V_lds + v_rd_base(lane);
  u32x4 sk0, sk1, sv;
  sk1 = u32x4{0u, 0u, 0u, 0u};
#define SLOAD(kt) do { const bfu* kp_ = Kh + (size_t)(kt) * 64 * DQK; sk0 = *reinterpret_cast<const u32x4*>(kp_ + kq0 * 8); \
    if (k2) sk1 = *reinterpret_cast<const u32x4*>(kp_ + kq1 * 8); sv = *reinterpret_cast<const u32x4*>(Vh + (size_t)(kt) * 64 * 64 + tid * 8); } while (0)
#define SWRITE(s) do { *reinterpret_cast<u32x4*>(K_lds + (s) * KT_BYTES + kst0) = sk0; if (k2) *reinterpret_cast<u32x4*>(K_lds + (s) * KT_BYTES + kst1) = sk1; \
    *reinterpret_cast<u32x4*>(V_lds + (s) * VT_BYTES + vst) = sv; } while (0)
#define RESC(a) do { if constexpr (!FAST) if (__any((a) < 1.f)) { _Pragma("unroll") for (int r = 0; r < 16; ++r) { o0[r] *= (a); o1[r] *= (a); } } } while (0)
  f32x16 pA0, pA1, pB0, pB1; float alA, alB; bf16x8 pa0, pa1, pa2, pa3;
  const int NT = nkeys / 64;
  __syncthreads();
  SLOAD(0); SWRITE(0); SLOAD(1);
  __syncthreads();
  SWRITE(1); SLOAD(2);
  qkt<DQK>(pA0, pA1, K_lds, qr, r32, hi); partialSM<FAST>(pA0, pA1, m_reg, alA);
  __syncthreads();
  int sa = 0, sb = 1, sc = 2;
  for (int j = 1; j + 1 < NT; j += 2) {
    SWRITE(sc); if (j + 2 < NT) SLOAD(j + 2);
    SBAR(); qkt<DQK>(pB0, pB1, K_lds + sb * KT_BYTES, qr, r32, hi); if constexpr (FAST) SBAR();
    finishSM<FAST>(pA0, pA1, alA, l_reg, pa0, pa1, pa2, pa3); SBAR();
    pv_all(o0, o1, vb0 + sa * VT_BYTES, pa0, pa1, pa2, pa3);
    partialSM<FAST>(pB0, pB1, m_reg, alB); RESC(alB);
    __syncthreads();
    SWRITE(sa); if (j + 3 < NT) SLOAD(j + 3);
    SBAR(); qkt<DQK>(pA0, pA1, K_lds + sc * KT_BYTES, qr, r32, hi); if constexpr (FAST) SBAR();
    finishSM<FAST>(pB0, pB1, alB, l_reg, pa0, pa1, pa2, pa3); SBAR();
    pv_all(o0, o1, vb0 + sb * VT_BYTES, pa0, pa1, pa2, pa3);
    partialSM<FAST>(pA0, pA1, m_reg, alA); RESC(alA);
    __syncthreads();
    { const int t_ = sa; sa = sc; sc = sb; sb = t_; }
  }
  SBAR(); qkt<DQK>(pB0, pB1, K_lds + sb * KT_BYTES, qr, r32, hi);
  finishSM<FAST>(pA0, pA1, alA, l_reg, pa0, pa1, pa2, pa3); SBAR();
  pv_all(o0, o1, vb0 + sa * VT_BYTES, pa0, pa1, pa2, pa3);
  partialSM<FAST>(pB0, pB1, m_reg, alB); RESC(alB);
  finishSM<FAST>(pB0, pB1, alB, l_reg, pa0, pa1, pa2, pa3); SBAR();
  pv_all(o0, o1, vb0 + sb * VT_BYTES, pa0, pa1, pa2, pa3);
#undef SLOAD
#undef SWRITE
#undef RESC
  if constexpr (FAST) {
    { auto rr = __builtin_amdgcn_permlane32_swap(__float_as_uint(l_reg), __float_as_uint(l_reg), false, false);
      l_reg = __uint_as_float(rr[0]) + __uint_as_float(rr[1]); }
    const int bad = !(l_reg > 1e-30f && l_reg < 1e30f);
    const int wbad = __any(bad) ? 1 : 0;
    __syncthreads();
    if (lane == 0) reinterpret_cast<int*>(lds)[wid] = wbad;
    __syncthreads();
    int anyb = 0;
#pragma unroll
    for (int w = 0; w < NTHR / 64; ++w) anyb |= reinterpret_cast<const int*>(lds)[w];
    if (anyb) return false;
  }
  const float inv = 1.f / l_reg;
  const int qrow = wid * 32 + r32;
  const bfu* pgr = pg + (size_t)qrow * INC;
  bfu* yr = yo + (size_t)qrow * 1024;
#pragma unroll
  for (int g4 = 0; g4 < 4; ++g4) {
    const int cbase = 8 * g4 + 4 * hi;
    {
      u32x2 gw = *reinterpret_cast<const u32x2*>(pgr + cbase);
      float a0 = o0[g4 * 4 + 0] * inv * siluf(bflo(gw[0])), a1 = o0[g4 * 4 + 1] * inv * siluf(bfhi(gw[0]));
      float a2 = o0[g4 * 4 + 2] * inv * siluf(bflo(gw[1])), a3 = o0[g4 * 4 + 3] * inv * siluf(bfhi(gw[1]));
      u32x2 w = {pk2(a0, a1), pk2(a2, a3)};
      *reinterpret_cast<u32x2*>(yr + cbase) = w;
    }
    {
      u32x2 gw = *reinterpret_cast<const u32x2*>(pgr + 32 + cbase);
      float a0 = o1[g4 * 4 + 0] * inv * siluf(bflo(gw[0])), a1 = o1[g4 * 4 + 1] * inv * siluf(bfhi(gw[0]));
      float a2 = o1[g4 * 4 + 2] * inv * siluf(bflo(gw[1])), a3 = o1[g4 * 4 + 3] * inv * siluf(bfhi(gw[1]));
      u32x2 w = {pk2(a0, a1), pk2(a2, a3)};
      *reinterpret_cast<u32x2*>(yr + 32 + cbase) = w;
    }
  }
  return true;
}

template <int DQK>
DEVI bool attn_unit_w128(const bfu* __restrict__ Q, const bfu* __restrict__ Kh, const bfu* __restrict__ Vh, int nkeys,
                         const bfu* __restrict__ pg, bfu* __restrict__ yo, char* lds, int tid) {
  constexpr int KROW = DQK * 2 + 16, KT_BYTES = 128 * KROW, VT_BYTES = 16384, CPR = DQK / 8, NKC = 128 * CPR / NTHR;
  const int wid = tid >> 6, lane = tid & 63, r32 = lane & 31, hi = lane >> 5;
  char* K_lds = lds; char* V_lds = lds + 2 * KT_BYTES;
  float l_reg = 0.f;
  f32x16 o0, o1;
#pragma unroll
  for (int r = 0; r < 16; ++r) { o0[r] = 0.f; o1[r] = 0.f; }
  bf16x8 qr[DQK / 16];
  {
    const bfu* Qw = Q + (size_t)(wid * 32 + r32) * DQK + hi * 8;
#pragma unroll
    for (int d0 = 0; d0 < DQK / 16; ++d0) qr[d0] = *reinterpret_cast<const bf16x8*>(Qw + d0 * 16);
  }
  int kst[NKC];
#pragma unroll
  for (int i = 0; i < NKC; ++i) { const int q_ = tid + i * NTHR; kst[i] = (q_ / CPR) * KROW + (q_ % CPR) * 16; }
  const int vst0 = v_st(tid >> 3, (tid & 7) * 8), vst1 = v_st(64 + (tid >> 3), (tid & 7) * 8);
  const int vb0 = (int)(uintptr_t)V_lds + v_rd_base(lane);
  u32x4 sk[NKC], sv0, sv1;
#define SLOAD(kt) do { const bfu* kp_ = Kh + (size_t)(kt) * 128 * DQK + tid * 8; _Pragma("unroll") for (int i = 0; i < NKC; ++i) sk[i] = *reinterpret_cast<const u32x4*>(kp_ + i * NTHR * 8); \
    const bfu* vp_ = Vh + (size_t)(kt) * 128 * 64 + tid * 8; sv0 = *reinterpret_cast<const u32x4*>(vp_); sv1 = *reinterpret_cast<const u32x4*>(vp_ + NTHR * 8); } while (0)
#define SWRITE(s) do { _Pragma("unroll") for (int i = 0; i < NKC; ++i) *reinterpret_cast<u32x4*>(K_lds + (s) * KT_BYTES + kst[i]) = sk[i]; \
    *reinterpret_cast<u32x4*>(V_lds + (s) * VT_BYTES + vst0) = sv0; *reinterpret_cast<u32x4*>(V_lds + (s) * VT_BYTES + vst1) = sv1; } while (0)
  const int NT = nkeys / 128;
  float m_dummy = 0.f, al_dummy = 1.f;
  __syncthreads();
  SLOAD(0); SWRITE(0);
  if (1 < NT) SLOAD(1);
  __syncthreads();
  for (int j = 0; j < NT; ++j) {
    const int sl = j & 1;
    if (j + 1 < NT) SWRITE(sl ^ 1);
    if (j + 2 < NT) SLOAD(j + 2);
    f32x16 p0, p1, p2, p3; bf16x8 pa0, pa1, pa2, pa3, pb0, pb1, pb2, pb3;
    qkt<DQK>(p0, p1, K_lds + sl * KT_BYTES, qr, r32, hi);
    qkt<DQK>(p2, p3, K_lds + sl * KT_BYTES + 64 * KROW, qr, r32, hi);
    finishSM<true>(p0, p1, al_dummy, l_reg, pa0, pa1, pa2, pa3);
    finishSM<true>(p2, p3, al_dummy, l_reg, pb0, pb1, pb2, pb3);
    SBAR();
    pv_all(o0, o1, vb0 + sl * VT_BYTES, pa0, pa1, pa2, pa3);
    pv_all(o0, o1, vb0 + sl * VT_BYTES + 8192, pb0, pb1, pb2, pb3);
    __syncthreads();
  }
#undef SLOAD
#undef SWRITE
  (void)m_dummy;
  { auto rr = __builtin_amdgcn_permlane32_swap(__float_as_uint(l_reg), __float_as_uint(l_reg), false, false);
    l_reg = __uint_as_float(rr[0]) + __uint_as_float(rr[1]); }
  {
    const int bad = !(l_reg > 1e-30f && l_reg < 1e30f);
    const int wbad = __any(bad) ? 1 : 0;
    __syncthreads();
    if (lane == 0) reinterpret_cast<int*>(lds)[wid] = wbad;
    __syncthreads();
    int anyb = 0;
#pragma unroll
    for (int w = 0; w < NTHR / 64; ++w) anyb |= reinterpret_cast<const int*>(lds)[w];
    if (anyb) return false;
  }
  const float inv = 1.f / l_reg;
  const int qrow = wid * 32 + r32;
  const bfu* pgr = pg + (size_t)qrow * INC;
  bfu* yr = yo + (size_t)qrow * 1024;
#pragma unroll
  for (int g4 = 0; g4 < 4; ++g4) {
    const int cbase = 8 * g4 + 4 * hi;
    {
      u32x2 gw = *reinterpret_cast<const u32x2*>(pgr + cbase);
      float a0 = o0[g4 * 4 + 0] * inv * siluf(bflo(gw[0])), a1 = o0[g4 * 4 + 1] * inv * siluf(bfhi(gw[0]));
      float a2 = o0[g4 * 4 + 2] * inv * siluf(bflo(gw[1])), a3 = o0[g4 * 4 + 3] * inv * siluf(bfhi(gw[1]));
      u32x2 w = {pk2(a0, a1), pk2(a2, a3)};
      *reinterpret_cast<u32x2*>(yr + cbase) = w;
    }
    {
      u32x2 gw = *reinterpret_cast<const u32x2*>(pgr + 32 + cbase);
      float a0 = o1[g4 * 4 + 0] * inv * siluf(bflo(gw[0])), a1 = o1[g4 * 4 + 1] * inv * siluf(bfhi(gw[0]));
      float a2 = o1[g4 * 4 + 2] * inv * siluf(bflo(gw[1])), a3 = o1[g4 * 4 + 3] * inv * siluf(bfhi(gw[1]));
      u32x2 w = {pk2(a0, a1), pk2(a2, a3)};
      *reinterpret_cast<u32x2*>(yr + 32 + cbase) = w;
    }
  }
  return true;
}

template <int DQK>
DEVI bool attn_unit_ks(const bfu* __restrict__ Q, const bfu* __restrict__ Kh, const bfu* __restrict__ Vh, int nkeys,
                       const bfu* __restrict__ pg, bfu* __restrict__ yo, char* lds, int tid) {
  constexpr int KROW = DQK * 2 + 16, KT_BYTES = 64 * KROW, VT_BYTES = 8192, KCH = 64 * (DQK / 8), CPR = DQK / 8, ND = DQK / 16;
  const int wid = tid >> 6, lane = tid & 63, r32 = lane & 31, hi = lane >> 5;
  const int qg = wid >> 1, kh = wid & 1;
  char* K_lds = lds; char* V_lds = lds + 3 * KT_BYTES;
  float l0 = 0.f, l1 = 0.f;
  f32x16 o00, o01, o10, o11;
#pragma unroll
  for (int r = 0; r < 16; ++r) { o00[r] = 0.f; o01[r] = 0.f; o10[r] = 0.f; o11[r] = 0.f; }
  bf16x8 qa[ND], qb[ND];
  {
    const bfu* Qw = Q + (size_t)(qg * 64 + r32) * DQK + hi * 8;
#pragma unroll
    for (int d0 = 0; d0 < ND; ++d0) { qa[d0] = *reinterpret_cast<const bf16x8*>(Qw + d0 * 16); qb[d0] = *reinterpret_cast<const bf16x8*>(Qw + 32 * DQK + d0 * 16); }
  }
  const bool k2 = (tid + 512) < KCH;
  const int kq0 = tid, kq1 = tid + 512;
  const int kst0 = (kq0 / CPR) * KROW + (kq0 % CPR) * 16, kst1 = (kq1 / CPR) * KROW + (kq1 % CPR) * 16;
  const int vst = v_st(tid >> 3, (tid & 7) * 8);
  const int vb0 = (int)(uintptr_t)V_lds + kh * 4096 + v_rd_base(lane);
  const int kfo = (kh * 32 + r32) * KROW + hi * 16;
  u32x4 sk0, sk1, sv;
  sk1 = u32x4{0u, 0u, 0u, 0u};
  const unsigned ko0 = (unsigned)kq0 * 16u, ko1 = (unsigned)kq1 * 16u, vo0 = (unsigned)tid * 16u;
#define SLOAD(kt) do { const char* kp_ = reinterpret_cast<const char*>(Kh) + (size_t)(kt) * (64 * DQK * 2); sk0 = *reinterpret_cast<const u32x4*>(kp_ + ko0); \
    if (k2) sk1 = *reinterpret_cast<const u32x4*>(kp_ + ko1); sv = *reinterpret_cast<const u32x4*>(reinterpret_cast<const char*>(Vh) + (size_t)(kt) * (64 * 64 * 2) + vo0); } while (0)
#define SWRITE(s) do { *reinterpret_cast<u32x4*>(K_lds + (s) * KT_BYTES + kst0) = sk0; if (k2) *reinterpret_cast<u32x4*>(K_lds + (s) * KT_BYTES + kst1) = sk1; \
    *reinterpret_cast<u32x4*>(V_lds + (s) * VT_BYTES + vst) = sv; } while (0)
  const int NT = nkeys / 64;
  __syncthreads();
  SLOAD(0); SWRITE(0); SLOAD(1);
  __syncthreads();
  int slot = 0, wslot = 1;
  for (int j = 0; j < NT; ++j) {
    if (j + 1 < NT) SWRITE(wslot);
    if (j + 2 < NT) SLOAD(j + 2);
    f32x16 pA, pB;
#pragma unroll
    for (int r = 0; r < 16; ++r) { pA[r] = 0.f; pB[r] = 0.f; }
    {
      const char* kp = K_lds + slot * KT_BYTES + kfo;
#pragma unroll
      for (int d0 = 0; d0 < ND; ++d0) {
        const bf16x8 kx = *reinterpret_cast<const bf16x8*>(kp + d0 * 32);
        pA = mfma32(kx, qa[d0], pA); pB = mfma32(kx, qb[d0], pB);
      }
    }
    float psA = 0.f, psB = 0.f;
#pragma unroll
    for (int r = 0; r < 16; ++r) { pA[r] = __builtin_amdgcn_exp2f(pA[r]); pB[r] = __builtin_amdgcn_exp2f(pB[r]); }
#pragma unroll
    for (int r = 0; r < 16; ++r) { psA += pA[r]; psB += pB[r]; }
    l0 += psA; l1 += psB;
    bf16x8 fA0, fA1, fB0, fB1;
#define PK8(P, BASE, OUT) do { u32x4 w = {cvtpk(P[BASE + 0], P[BASE + 1]), cvtpk(P[BASE + 2], P[BASE + 3]), cvtpk(P[BASE + 4], P[BASE + 5]), cvtpk(P[BASE + 6], P[BASE + 7])}; \
    OUT = *reinterpret_cast<bf16x8*>(&w); } while (0)
    PK8(pA, 0, fA0); PK8(pA, 8, fA1); PK8(pB, 0, fB0); PK8(pB, 8, fB1);
#undef PK8
    SBAR();
    {
      const int vb = vb0 + slot * VT_BYTES;
#define PK(L, H) (bf16x8){L[0], L[1], L[2], L[3], H[0], H[1], H[2], H[3]}
      {
        const s16x4 a0 = tr_read<v_rd_off(0, 0, 0)>(vb), b0 = tr_read<v_rd_off(0, 0, 1)>(vb), c0 = tr_read<v_rd_off(1, 0, 0)>(vb), d0_ = tr_read<v_rd_off(1, 0, 1)>(vb);
        asm volatile("s_waitcnt lgkmcnt(0)" ::: "memory"); SBAR();
        const bf16x8 v00 = PK(a0, b0), v10 = PK(c0, d0_);
        o00 = mfma32(v00, fA0, o00); o01 = mfma32(v10, fA0, o01); o10 = mfma32(v00, fB0, o10); o11 = mfma32(v10, fB0, o11);
      }
      SBAR();
      {
        const s16x4 a1 = tr_read<v_rd_off(0, 1, 0)>(vb), b1 = tr_read<v_rd_off(0, 1, 1)>(vb), c1 = tr_read<v_rd_off(1, 1, 0)>(vb), d1_ = tr_read<v_rd_off(1, 1, 1)>(vb);
        asm volatile("s_waitcnt lgkmcnt(0)" ::: "memory"); SBAR();
        const bf16x8 v01 = PK(a1, b1), v11 = PK(c1, d1_);
        o00 = mfma32(v01, fA1, o00); o01 = mfma32(v11, fA1, o01); o10 = mfma32(v01, fB1, o10); o11 = mfma32(v11, fB1, o11);
      }
#undef PK
    }
    __syncthreads();
    slot = (slot == 2) ? 0 : slot + 1; wslot = (wslot == 2) ? 0 : wslot + 1;
  }
#undef SLOAD
#undef SWRITE
  float* cbuf = reinterpret_cast<float*>(lds);
  float* mine = cbuf + wid * (33 * 64) + lane;
  const float* theirs = cbuf + (wid ^ 1) * (33 * 64) + lane;
  f32x16 o0, o1; float l_reg;
  if (kh) {
#pragma unroll
    for (int r = 0; r < 16; ++r) { mine[r * 64] = o00[r]; mine[(16 + r) * 64] = o01[r]; }
    mine[32 * 64] = l0;
    o0 = o10; o1 = o11; l_reg = l1;
  } else {
#pragma unroll
    for (int r = 0; r < 16; ++r) { mine[r * 64] = o10[r]; mine[(16 + r) * 64] = o11[r]; }
    mine[32 * 64] = l1;
    o0 = o00; o1 = o01; l_reg = l0;
  }
  __syncthreads();
#pragma unroll
  for (int r = 0; r < 16; ++r) { o0[r] += theirs[r * 64]; o1[r] += theirs[(16 + r) * 64]; }
  l_reg += theirs[32 * 64];
  { auto rr = __builtin_amdgcn_permlane32_swap(__float_as_uint(l_reg), __float_as_uint(l_reg), false, false);
    l_reg = __uint_as_float(rr[0]) + __uint_as_float(rr[1]); }
  {
    const int bad = !(l_reg > 1e-30f && l_reg < 1e30f);
    const int wbad = __any(bad) ? 1 : 0;
    __syncthreads();
    if (lane == 0) reinterpret_cast<int*>(lds)[wid] = wbad;
    __syncthreads();
    int anyb = 0;
#pragma unroll
    for (int w = 0; w < NTHR / 64; ++w) anyb |= reinterpret_cast<const int*>(lds)[w];
    if (anyb) return false;
  }
  const float inv = 1.f / l_reg;
  const int qrow = qg * 64 + kh * 32 + r32;
  const bfu* pgr = pg + (size_t)qrow * INC;
  bfu* yr = yo + (size_t)qrow * 1024;
#pragma unroll
  for (int g4 = 0; g4 < 4; ++g4) {
    const int cbase = 8 * g4 + 4 * hi;
    {
      u32x2 gw = *reinterpret_cast<const u32x2*>(pgr + cbase);
      float a0 = o0[g4 * 4 + 0] * inv * siluf(bflo(gw[0])), a1 = o0[g4 * 4 + 1] * inv * siluf(bfhi(gw[0]));
      float a2 = o0[g4 * 4 + 2] * inv * siluf(bflo(gw[1])), a3 = o0[g4 * 4 + 3] * inv * siluf(bfhi(gw[1]));
      u32x2 w = {pk2(a0, a1), pk2(a2, a3)};
      *reinterpret_cast<u32x2*>(yr + cbase) = w;
    }
    {
      u32x2 gw = *reinterpret_cast<const u32x2*>(pgr + 32 + cbase);
      float a0 = o1[g4 * 4 + 0] * inv * siluf(bflo(gw[0])), a1 = o1[g4 * 4 + 1] * inv * siluf(bfhi(gw[0]));
      float a2 = o1[g4 * 4 + 2] * inv * siluf(bflo(gw[1])), a3 = o1[g4 * 4 + 3] * inv * siluf(bfhi(gw[1]));
      u32x2 w = {pk2(a0, a1), pk2(a2, a3)};
      *reinterpret_cast<u32x2*>(yr + 32 + cbase) = w;
    }
  }
  return true;
}

template <bool FAST> DEVI bool attn_dispatch(const Params& P, int b, int head12, int qb, bool ctxq, char* lds, int tid) {
  const bfu* pbuf = reinterpret_cast<const bfu*>(P.ws + O_P);
  bfu* yb = reinterpret_cast<bfu*>(P.ws + O_H);
  const int t0 = ctxq ? SEQ : qb * 256;
  const int row0 = ctxq ? ML + b * CTX : b * SEQ + qb * 256;
  const int kt0 = ctxq ? SEQ : 0, nkeys = ctxq ? CTX : TK;
  if (head12 < 6) {
    const int h = head12;
    const bfu* Q = reinterpret_cast<const bfu*>(P.ws + O_QM) + ((size_t)(b * 6 + h) * TK + t0) * 96;
    const bfu* K = reinterpret_cast<const bfu*>(P.ws + O_KM) + ((size_t)(b * 6 + h) * TK + kt0) * 96;
    const bfu* V = reinterpret_cast<const bfu*>(P.ws + O_VM) + ((size_t)(b * 6 + h) * TK + kt0) * 64;
    if constexpr (FAST) return attn_unit_w128<96>(Q, K, V, nkeys, pbuf + (size_t)row0 * INC + PC_GATE + h * 64, yb + (size_t)row0 * 1024 + h * 64, lds, tid);
    else return attn_unit<96, false>(Q, K, V, nkeys, pbuf + (size_t)row0 * INC + PC_GATE + h * 64, yb + (size_t)row0 * 1024 + h * 64, lds, tid);
  } else {
    const int h = head12 - 6, g = h / 3;
    const bfu* Q = reinterpret_cast<const bfu*>(P.ws + O_QG) + ((size_t)(b * 6 + h) * TK + t0) * 64;
    const bfu* K = reinterpret_cast<const bfu*>(P.ws + O_KG) + ((size_t)(b * 2 + g) * TK + kt0) * 64;
    const bfu* V = reinterpret_cast<const bfu*>(P.ws + O_VG) + ((size_t)(b * 2 + g) * TK + kt0) * 64;
    return attn_unit<64, FAST>(Q, K, V, nkeys, pbuf + (size_t)row0 * INC + PC_GATE + 384 + h * 64, yb + (size_t)row0 * 1024 + 384 + h * 64, lds, tid);
  }
}

template <bool FAST> DEVI unsigned phase_attn(int wv, const Params& P, bool last, char* lds, unsigned mask) {
  const int tid = otid(wv);
  int grp, loc, per, ngrp; blk_group(grp, loc, per, ngrp);
  const int UL = (NB / ngrp) * 192, UC = last ? 0 : (NB / ngrp) * 12;
  unsigned bad = 0u; int k = 0;
  for (int u = loc; u < UL + UC; u += per, ++k) {
    if (!FAST && !((mask >> (k & 31)) & 1u)) continue;
    bool ok;
    if (u < UL) { const int ug = grp * UL + u; ok = attn_dispatch<FAST>(P, ug / 192, (ug % 192) >> 4, ug & 15, false, lds, tid); }
    else { const int ug = grp * UC + (u - UL); ok = attn_dispatch<FAST>(P, ug / 12, ug % 12, 0, true, lds, tid); }
    if (!ok) bad |= 1u << (k & 31);
  }
  return bad;
}

DEVI void phase_gemm_out(int wv, const Params& P, int layer, bool last, char* lds) {
  const int tid = otid(wv);
  const bfu* A = reinterpret_cast<const bfu*>(P.ws + O_H);
  const bfu* Bt = reinterpret_cast<const bfu*>(P.ws + O_WOUT + layer * SZ_WOUT);
  const int PANELS = last ? ML / 256 : MT / 256;
  constexpr int NT = 8;
  int grp, loc, per, ngrp; blk_group(grp, loc, per, ngrp);
  const int PG = PANELS / ngrp, g0 = grp * PG;
  u32x4 ra[4], rb[2]; bool pref = false;
  for (int tl = loc; tl < PG * NT; tl += per) {
    const int tn = tl + per;
    NextTile nx{A, Bt, 1024, 1024, (g0 + tn / NT) * 256, (tn % NT) * 128, tn < PG * NT};
    gemm_tile<EPI_OUT, 2>(A, 1024, Bt, 1024, 1024, (g0 + tl / NT) * 256, (tl % NT) * 128, lds, P, layer, tid, ra, rb, pref, nx);
    pref = nx.valid;
  }
}

DEVI void phase_final(int wv, const Params& P) {
  const int tid = otid(wv), wid = tid >> 6, lane = tid & 63;
  const int gw = blockIdx.x * (NTHR / 64) + wid, nw = gridDim.x * (NTHR / 64);
  const int b = gw & 7, i0 = gw >> 3, istep = nw >> 3;
  const size_t ro = (size_t)b * SEQ * 1024;
  float* xo = P.out + ro;
  const bfu* dsrc = reinterpret_cast<const bfu*>(P.ws + O_D) + ro;
  const float* g1v = reinterpret_cast<const float*>(P.ws + O_MOD) + (size_t)9 * 3072 + (size_t)b * 3072 + 2048;
  f32x4 GW[4], G1[4];
#pragma unroll
  for (int i = 0; i < 4; ++i) { GW[i] = *reinterpret_cast<const f32x4*>(P.final_norm_w + (i * 64 + lane) * 4); G1[i] = *reinterpret_cast<const f32x4*>(g1v + (i * 64 + lane) * 4); }
  f32x4 XA[2][4], XB[2][4]; u32x2 DA[2][4], DB[2][4];
#define LOADSET(X, D, IB) do { _Pragma("unroll") for (int q = 0; q < 2; ++q) { const int idx = (IB) + q * istep; if (idx < SEQ) { \
      _Pragma("unroll") for (int i = 0; i < 4; ++i) { X[q][i] = *reinterpret_cast<const f32x4*>(xo + (size_t)idx * 1024 + (i * 64 + lane) * 4); \
        D[q][i] = *reinterpret_cast<const u32x2*>(dsrc + (size_t)idx * 1024 + (i * 64 + lane) * 4); } } } } while (0)
#define PROCSET(X, D, IB) do { _Pragma("unroll") for (int q = 0; q < 2; ++q) { const int idx = (IB) + q * istep; if (idx < SEQ) { \
      float ss = 0.f; \
      _Pragma("unroll") for (int i = 0; i < 4; ++i) { \
        X[q][i][0] += G1[i][0] * bflo(D[q][i][0]); X[q][i][1] += G1[i][1] * bfhi(D[q][i][0]); \
        X[q][i][2] += G1[i][2] * bflo(D[q][i][1]); X[q][i][3] += G1[i][3] * bfhi(D[q][i][1]); \
        ss += X[q][i][0] * X[q][i][0] + X[q][i][1] * X[q][i][1] + X[q][i][2] * X[q][i][2] + X[q][i][3] * X[q][i][3]; } \
      ss = wsum(ss); \
      const float r = rsqrtf(ss * (1.f / 1024.f) + EPS); \
      _Pragma("unroll") for (int i = 0; i < 4; ++i) { \
        f32x4 o = {X[q][i][0] * r * GW[i][0], X[q][i][1] * r * GW[i][1], X[q][i][2] * r * GW[i][2], X[q][i][3] * r * GW[i][3]}; \
        *reinterpret_cast<f32x4*>(xo + (size_t)idx * 1024 + (i * 64 + lane) * 4) = o; } } } } while (0)
  int ib = i0;
  LOADSET(XA, DA, ib);
  while (ib < SEQ) {
    LOADSET(XB, DB, ib + 2 * istep);
    PROCSET(XA, DA, ib);
    ib += 2 * istep; if (ib >= SEQ) break;
    LOADSET(XA, DA, ib + 2 * istep);
    PROCSET(XB, DB, ib);
    ib += 2 * istep;
  }
#undef LOADSET
#undef PROCSET
}

DEVI bool is_t0(int wv) { return wv == 0 && __builtin_amdgcn_mbcnt_hi(~0u, __builtin_amdgcn_mbcnt_lo(~0u, 0u)) == 0u; }
#define XB_TMO      128
#define XB_XCNT(j)  (256  + 64 * (j))
#define XB_XSUB(j)  (1280 + 64 * (j))
#define XB_XGEN(j)  (2304 + 64 * (j))
#define XB_TOP      3328
#define XB_TOPGEN   3392
#define XB_SPIN_CAP (1u << 18)
#define LAS __attribute__((address_space(3)))
DEVI unsigned xb_ld(unsigned* p)              { return __hip_atomic_load(p, __ATOMIC_RELAXED, __HIP_MEMORY_SCOPE_AGENT); }
DEVI unsigned xb_add(unsigned* p, unsigned v) { return __hip_atomic_fetch_add(p, v, __ATOMIC_RELAXED, __HIP_MEMORY_SCOPE_AGENT); }
DEVI unsigned xb_xcc_id() { return (unsigned)__builtin_amdgcn_s_getreg((3 << 11) | 20) & 0xFu; }
#define XB_SPIN(cond, bar) do { unsigned _sp = 0; while (cond) { __builtin_amdgcn_s_sleep(1); \
    if ((++_sp & 255u) == 0u) { if (xb_ld(&(bar)[XB_TMO])) break; if (_sp > XB_SPIN_CAP) { atomicAdd(&(bar)[XB_TMO], 1u); break; } } } } while (0)
DEVI void xcd_barrier_complete(unsigned* bar, unsigned x, unsigned& nloc, unsigned& nx) {
  const unsigned G = gridDim.x * gridDim.y * gridDim.z;
  unsigned sum, cnt, mine, sp = 0u;
  for (;;) {
    sum = 0u; cnt = 0u; mine = 0u;
#pragma unroll
    for (unsigned j = 0; j < 16; ++j) { const unsigned c = xb_ld(&bar[XB_XCNT(j)]); sum += c; cnt += (c > 0u) ? 1u : 0u; mine = (j == x) ? c : mine; }
    if (sum == G) break;
    __builtin_amdgcn_s_sleep(1);
    if ((++sp & 255u) == 0u) { if (xb_ld(&bar[XB_TMO])) break; if (sp > XB_SPIN_CAP) { atomicAdd(&bar[XB_TMO], 1u); break; } }
  }
  nloc = mine > 0u ? mine : 1u; nx = cnt > 0u ? cnt : 1u;
}
DEVI void xcd_barrier(char* ws, char* lds, int wv) {
  asm volatile("s_waitcnt vmcnt(0)" ::: "memory");
  __syncthreads();
  if (is_t0(wv)) {
    unsigned* bar = reinterpret_cast<unsigned*>(ws + O_XBAR);
    volatile LAS unsigned* st = (volatile LAS unsigned*)(unsigned)((unsigned)(uintptr_t)lds + LDS_BYTES);
    const unsigned x = xb_xcc_id();
    __builtin_amdgcn_s_waitcnt(0);
    unsigned nloc = st[0], nx = st[1];
    if (nloc == 0u) { xcd_barrier_complete(bar, x, nloc, nx); st[0] = nloc; st[1] = nx; }
    const unsigned old = xb_add(&bar[XB_XSUB(x)], 1u);
    const unsigned gen = old / nloc;
    if (old + 1u == (gen + 1u) * nloc) {
      __builtin_amdgcn_fence(__ATOMIC_RELEASE, "agent");
      asm volatile("s_waitcnt vmcnt(0)" ::: "memory");
      const unsigned og = xb_add(&bar[XB_TOP], 1u);
      const unsigned tg = og / nx;
      if (og + 1u == (tg + 1u) * nx) xb_add(&bar[XB_TOPGEN], 1u);
      else XB_SPIN(xb_ld(&bar[XB_TOPGEN]) == tg, bar);
      __builtin_amdgcn_fence(__ATOMIC_ACQUIRE, "agent");
      xb_add(&bar[XB_XGEN(x)], 1u);
      asm volatile("s_waitcnt vmcnt(0)" ::: "memory");
    } else {
      XB_SPIN(xb_ld(&bar[XB_XGEN(x)]) == gen, bar);
      __builtin_amdgcn_fence(__ATOMIC_ACQUIRE, "agent");
      asm volatile("s_waitcnt vmcnt(0)" ::: "memory");
    }
  }
  __syncthreads();
}

DEVI void gsync(unsigned* ctr, unsigned gen, int wv) {
  asm volatile("s_waitcnt vmcnt(0)" ::: "memory");
  __syncthreads();
  if (is_t0(wv)) {
    __builtin_amdgcn_fence(__ATOMIC_RELEASE, "agent");
    asm volatile("s_waitcnt vmcnt(0)" ::: "memory");
    __hip_atomic_fetch_add(ctr, 1u, __ATOMIC_RELAXED, __HIP_MEMORY_SCOPE_AGENT);
    const unsigned target = gen * gridDim.x;
    while (__hip_atomic_load(ctr, __ATOMIC_RELAXED, __HIP_MEMORY_SCOPE_AGENT) < target) __builtin_amdgcn_s_sleep(1);
    __builtin_amdgcn_fence(__ATOMIC_ACQUIRE, "agent");
    asm volatile("s_waitcnt vmcnt(0)" ::: "memory");
  }
  __syncthreads();
}

#ifndef PH_MASK
#define PH_MASK 0xff
#endif
#ifndef REP_MASK
#define REP_MASK 0
#endif
__global__ void __launch_bounds__(NTHR) fwd_megakernel(Params P) {
  extern __shared__ __attribute__((aligned(16))) char lds[];
  cg::grid_group grid = cg::this_grid();
  const int wv = __builtin_amdgcn_readfirstlane((int)(threadIdx.x >> 6));
  {
    volatile LAS unsigned* xst = (volatile LAS unsigned*)(unsigned)((unsigned)(uintptr_t)lds + LDS_BYTES);
    if (threadIdx.x == 0) { xst[0] = 0u; xst[1] = 0u; (void)xb_add(reinterpret_cast<unsigned*>(P.ws + O_XBAR) + XB_XCNT(xb_xcc_id()), 1u); }
    __syncthreads();
  }
  if constexpr (PH_MASK & 1) phase_prep(wv, P, lds);
  grid.sync();
#pragma nounroll
  for (int layer = 0; layer < 2; ++layer) {
    const bool last = layer == 1;
    unsigned* bar = reinterpret_cast<unsigned*>(ows(P.ws + O_BAR));
    const unsigned g0 = layer * 6;
    if constexpr (PH_MASK & 2) phase_hnorm(wv, P, layer);
    if constexpr (PH_MASK & 1) { if (layer == 0) phase_wprep(wv, P); }
    xcd_barrier(P.ws, lds, wv);
    if constexpr (PH_MASK & 4) phase_gemm_in(wv, P, layer, last, lds);
    xcd_barrier(P.ws, lds, wv);
    if constexpr (PH_MASK & 8) phase_rows(wv, P, layer, last, lds);
    if constexpr (REP_MASK & 8) { __syncthreads(); phase_rows(wv, P, layer, last, lds); }
    xcd_barrier(P.ws, lds, wv);
    if constexpr (PH_MASK & 16) phase_gemm_mid(wv, P, layer, last, lds);
    if constexpr (REP_MASK & 16) { __syncthreads(); phase_gemm_mid(wv, P, layer, last, lds); }
    xcd_barrier(P.ws, lds, wv);
    unsigned badmask = 0u;
    if constexpr (PH_MASK & 32) badmask = phase_attn<true>(wv, P, last, lds, 0u);
    if (badmask && is_t0(wv)) __hip_atomic_fetch_add(bar + 16 + layer, 1u, __ATOMIC_RELAXED, __HIP_MEMORY_SCOPE_AGENT);
    xcd_barrier(P.ws, lds, wv);
    if (__hip_atomic_load(bar + 16 + layer, __ATOMIC_RELAXED, __HIP_MEMORY_SCOPE_AGENT) != 0u) {
      if constexpr (PH_MASK & 32) phase_attn<false>(wv, P, last, lds, badmask);
      xcd_barrier(P.ws, lds, wv);
    }
    if constexpr (PH_MASK & 64) phase_gemm_out(wv, P, layer, last, lds);
    if constexpr (REP_MASK & 64) { if (!last) { __syncthreads(); phase_gemm_out(wv, P, layer, last, lds); } }
    xcd_barrier(P.ws, lds, wv);
  }
  if constexpr (PH_MASK & 128) phase_final(wv, P);
}

extern "C" void kernel_launch(void* const* d_in, const int* in_sizes, int n_in, void* d_out, int out_size, void* d_ws, size_t ws_size, hipStream_t stream) {
  static int grid_blocks = 0;
  if (!grid_blocks) {
    int dev = 0, cus = 0, per_cu = 0;
    hipGetDevice(&dev);
    hipDeviceGetAttribute(&cus, hipDeviceAttributeMultiprocessorCount, dev);
    hipFuncSetAttribute((const void*)fwd_megakernel, hipFuncAttributeMaxDynamicSharedMemorySize, LDS_BYTES + 16);
    hipOccupancyMaxActiveBlocksPerMultiprocessor(&per_cu, fwd_megakernel, NTHR, LDS_BYTES + 16);
    if (per_cu < 1) { fprintf(stderr, "kernel_launch: occupancy query returned %d\n", per_cu); per_cu = 1; }
    grid_blocks = cus;
    if (ws_size < O_END) fprintf(stderr, "kernel_launch: workspace too small: %zu < %zu\n", ws_size, (size_t)O_END);
  }
  Params p{};
  const float** f = reinterpret_cast<const float**>(&p);
  for (int i = 0; i < 22; ++i) f[i] = static_cast<const float*>(d_in[i]);
  p.out = static_cast<float*>(d_out);
  p.ws = static_cast<char*>(d_ws);
  hipMemsetAsync(p.ws + O_BAR, 0, 256 + 3456 * 4, stream);
  void* args[] = {&p};
  hipError_t e = hipLaunchCooperativeKernel((const void*)fwd_megakernel, dim3(grid_blocks), dim3(NTHR), args, LDS_BYTES + 16, stream);
  if (e != hipSuccess) fprintf(stderr, "cooperative launch failed: %s (grid %d)\n", hipGetErrorString(e), grid_blocks);
}
```

```cpp
#include <hip/hip_runtime.h>
#include <hip/hip_cooperative_groups.h>
#include <cstdio>
#include <cstdint>
namespace cg = cooperative_groups;

#define DEVI __device__ __forceinline__
typedef unsigned short bfu;
typedef __attribute__((ext_vector_type(8))) short bf16x8;
typedef __attribute__((ext_vector_type(4))) short s16x4;
typedef __attribute__((ext_vector_type(16))) float f32x16;
typedef __attribute__((ext_vector_type(4))) float f32x4;
typedef __attribute__((ext_vector_type(4))) unsigned u32x4;
typedef __attribute__((ext_vector_type(2))) unsigned u32x2;

constexpr int NB = 8, SEQ = 4096, DM = 1024, CTX = 256, TK = SEQ + CTX;
constexpr int ML = NB * SEQ, MC = NB * CTX, MT = ML + MC;
constexpr int INC = 2592, INP = 2816;
constexpr int NTHR = 512;
constexpr float EPS = 1e-6f;
constexpr float LOG2E = 1.4426950408889634f;
constexpr float QS_M = 0.10206207261596575f * LOG2E;
constexpr float QS_G = 0.125f * LOG2E;
constexpr int PC_MLAQ = 0, PC_KV = 256, PC_KR = 384, PC_GK = 416, PC_GV = 544, PC_GQ = 672, PC_CONV = 1056, PC_GATE = 1568;

constexpr size_t al256(size_t x) { return (x + 255) / 256 * 256; }
constexpr size_t SZ_WIN = (size_t)INP * 1024 * 2, SZ_WUQ = (size_t)640 * 256 * 2, SZ_WUKV = (size_t)768 * 128 * 2, SZ_WPW = (size_t)256 * 256 * 2,
                 SZ_WOUT = (size_t)1024 * 1024 * 2;
constexpr size_t O_WIN = 0;
constexpr size_t O_WUQ = O_WIN + 2 * SZ_WIN;
constexpr size_t O_WUKV = O_WUQ + 2 * SZ_WUQ;
constexpr size_t O_WPW = O_WUKV + 2 * SZ_WUKV;
constexpr size_t O_WOUT = O_WPW + 2 * SZ_WPW;
constexpr size_t O_MOD = O_WOUT + 2 * SZ_WOUT;
constexpr size_t O_ROPE = O_MOD + al256((size_t)2 * 9 * 3072 * 4);
constexpr size_t O_STATS = O_ROPE + al256((size_t)3072 * 4);
constexpr size_t O_CTX1 = O_STATS + al256((size_t)MT * 2 * 4);
constexpr size_t O_H = O_CTX1 + (size_t)MC * 1024 * 4;
constexpr size_t O_P = O_H + (size_t)MT * 1024 * 2;
constexpr size_t O_QM = O_P + (size_t)MT * INC * 2;
constexpr size_t O_KM = O_QM + (size_t)NB * 6 * TK * 96 * 2;
constexpr size_t O_VM = O_KM + (size_t)NB * 6 * TK * 96 * 2;
constexpr size_t O_QG = O_VM + (size_t)NB * 6 * TK * 64 * 2;
constexpr size_t O_KG = O_QG + (size_t)NB * 6 * TK * 64 * 2;
constexpr size_t O_VG = O_KG + (size_t)NB * 2 * TK * 64 * 2;
constexpr size_t O_Z = O_VG + (size_t)NB * 2 * TK * 64 * 2;
constexpr size_t O_BAR = O_Z + (size_t)MT * 256 * 2;
constexpr size_t O_D = O_QM;
static_assert((size_t)MT * 1024 * 2 <= O_VM - O_QM, "d does not fit");
constexpr size_t O_XBAR = O_BAR + 256;
constexpr size_t O_END = O_XBAR + 3456 * 4;

struct Params {
  const float *x, *c, *ctx, *c_ctx, *norm_w, *w_mod, *b_mod, *w_in, *mla_q_norm, *mla_w_uq, *mla_kv_norm, *mla_w_ukv, *gqa_q_norm, *gqa_k_norm,
      *conv_dw_w, *conv_dw_b, *conv_ln_w, *conv_ln_b, *conv_pw_w, *conv_pw_b, *w_out, *final_norm_w;
  float* out;
  char* ws;
};

DEVI unsigned short f2bf(float f) { unsigned u = __float_as_uint(f); u += 0x7fffu + ((u >> 16) & 1u); return (unsigned short)(u >> 16); }
DEVI float bf2f(unsigned short h) { return __uint_as_float(((unsigned)h) << 16); }
DEVI unsigned pk2(float lo, float hi) { return (unsigned)f2bf(lo) | ((unsigned)f2bf(hi) << 16); }
DEVI unsigned cvtpk(float lo, float hi) { unsigned r; asm volatile("v_cvt_pk_bf16_f32 %0, %1, %2" : "=v"(r) : "v"(lo), "v"(hi)); return r; }
DEVI float bflo(unsigned w) { return __uint_as_float(w << 16); }
DEVI float bfhi(unsigned w) { return __uint_as_float(w & 0xffff0000u); }
DEVI int otid(int wv) { int t = (wv << 6) | (int)__builtin_amdgcn_mbcnt_hi(~0u, __builtin_amdgcn_mbcnt_lo(~0u, 0u)); asm volatile("" : "+v"(t)); return t; }
DEVI int obid() { int t = blockIdx.x; asm volatile("" : "+s"(t)); return t; }
DEVI char* ows(const char* p) { char* q = const_cast<char*>(p); asm volatile("" : "+s"(q)); return q; }
template <int X> DEVI float swz_xor(float v) { return __int_as_float(__builtin_amdgcn_ds_swizzle(__float_as_int(v), (X << 10) | 0x1f)); }
DEVI float wsum(float v) {
  v += swz_xor<1>(v); v += swz_xor<2>(v); v += swz_xor<4>(v); v += swz_xor<8>(v); v += swz_xor<16>(v);
  auto rr = __builtin_amdgcn_permlane32_swap(__float_as_uint(v), __float_as_uint(v), false, false);
  return __uint_as_float(rr[0]) + __uint_as_float(rr[1]);
}
DEVI float siluf(float v) { return v * __builtin_amdgcn_rcpf(1.f + __expf(-v)); }
DEVI int crow(int r, int hi) { return (r & 3) + 8 * (r >> 2) + 4 * hi; }
DEVI f32x16 mfma32(bf16x8 a, bf16x8 b, f32x16 c) { return __builtin_amdgcn_mfma_f32_32x32x16_bf16(a, b, c, 0, 0, 0); }

DEVI void rowinfo(int row, int& b, int& t, int& v) {
  if (row < ML) { b = row >> 12; t = row & 4095; v = b; }
  else { int rc = row - ML; b = rc >> 8; t = SEQ + (rc & 255); v = 8; }
}

DEVI void prep_transpose(const float* __restrict__ src, bfu* __restrict__ dst, int K, int N, int Npad, const float* __restrict__ gk, int gtid, int gthreads) {
  const int items = Npad * (K / 8);
  for (int i = gtid; i < items; i += gthreads) {
    const int n = i % Npad, k8 = i / Npad;
    u32x4 w = {0u, 0u, 0u, 0u};
    if (n < N) {
      float v[8];
#pragma unroll
      for (int j = 0; j < 8; ++j) { float s = src[(size_t)(k8 * 8 + j) * N + n]; if (gk) s *= gk[k8 * 8 + j]; v[j] = s; }
      w[0] = pk2(v[0], v[1]); w[1] = pk2(v[2], v[3]); w[2] = pk2(v[4], v[5]); w[3] = pk2(v[6], v[7]);
    }
    *reinterpret_cast<u32x4*>(dst + (size_t)n * K + k8 * 8) = w;
  }
}

DEVI void sincos_d(double a, float& c, float& s) {
  const double TWO_PI = 6.283185307179586476925286766559;
  double k = rint(a / TWO_PI);
  double r = a - k * TWO_PI;
  double r2 = r * r, ts = r, ss = r, tc = 1.0, cc = 1.0;
#pragma unroll
  for (int n = 1; n <= 14; ++n) {
    ts *= -r2 / (double)((2 * n) * (2 * n + 1)); ss += ts;
    tc *= -r2 / (double)((2 * n - 1) * (2 * n)); cc += tc;
  }
  c = (float)cc; s = (float)ss;
}

DEVI void phase_prep(int wv, const Params& P, char* lds) {
  const int tid = otid(wv), wid = tid >> 6, lane = tid & 63;
  const int gtid = blockIdx.x * NTHR + tid, gthreads = gridDim.x * NTHR;
  float* sc = reinterpret_cast<float*>(lds);
  float* part = sc + 9 * 1024;
  float* mod = reinterpret_cast<float*>(P.ws + O_MOD);
  bool staged = false;
  for (int it = blockIdx.x; it < 96; it += gridDim.x) {
    if (!staged) {
      for (int idx = tid; idx < 9 * 1024; idx += NTHR) {
        int v = idx >> 10, k = idx & 1023;
        float cv = (v < 8) ? P.c[v * 1024 + k] : P.c_ctx[k];
        sc[idx] = siluf(cv);
      }
      staged = true;
    }
    __syncthreads();
    const int l = it / 48, j0 = (it % 48) * 64;
    const float* wm = P.w_mod + (size_t)l * 1024 * 3072 + j0 + lane;
    float acc[9];
#pragma unroll
    for (int v = 0; v < 9; ++v) acc[v] = 0.f;
    for (int k = wid * 128; k < wid * 128 + 128; k += 16) {
      float wv[16];
#pragma unroll
      for (int u = 0; u < 16; ++u) wv[u] = wm[(size_t)(k + u) * 3072];
#pragma unroll
      for (int v = 0; v < 9; ++v) {
        const float* s_ = sc + v * 1024 + k;
        float a_ = 0.f;
#pragma unroll
        for (int u = 0; u < 16; ++u) a_ += s_[u] * wv[u];
        acc[v] += a_;
      }
    }
#pragma unroll
    for (int v = 0; v < 9; ++v) part[(wid * 9 + v) * 64 + lane] = acc[v];
    __syncthreads();
    for (int o = tid; o < 9 * 64; o += NTHR) {
      int v = o >> 6, jl = o & 63;
      float s = P.b_mod[l * 3072 + j0 + jl];
#pragma unroll
      for (int w = 0; w < 8; ++w) s += part[(w * 9 + v) * 64 + jl];
      mod[((size_t)l * 9 + v) * 3072 + j0 + jl] = s;
    }
    __syncthreads();
  }
  if (gtid < 1536) {
    float* rt = reinterpret_cast<float*>(P.ws + O_ROPE);
    int pos, i, half; float* cdst; float* sdst;
    if (gtid < 512) { pos = gtid >> 3; i = gtid & 7; half = 8; cdst = rt + gtid; sdst = rt + 512 + gtid; }
    else { int g = gtid - 512; pos = g >> 4; i = g & 15; half = 16; cdst = rt + 1024 + g; sdst = rt + 2048 + g; }
    float freq = exp2f(-(float)i / (float)half * 13.287712379549449f);
    float ang = (float)pos * freq;
    float c, s; sincos_d((double)ang, c, s);
    *cdst = c; *sdst = s;
  }
}

DEVI void phase_wprep(int wv, const Params& P) {
  const int tid = otid(wv);
  const int gtid = blockIdx.x * NTHR + tid, gthreads = gridDim.x * NTHR;
  for (int l = 0; l < 2; ++l) {
    prep_transpose(P.w_in + (size_t)l * 1024 * INC, reinterpret_cast<bfu*>(P.ws + O_WIN + l * SZ_WIN), 1024, INC, INP, nullptr, gtid, gthreads);
    prep_transpose(P.mla_w_uq + (size_t)l * 256 * 576, reinterpret_cast<bfu*>(P.ws + O_WUQ + l * SZ_WUQ), 256, 576, 640, P.mla_q_norm + l * 256, gtid, gthreads);
    prep_transpose(P.mla_w_ukv + (size_t)l * 128 * 768, reinterpret_cast<bfu*>(P.ws + O_WUKV + l * SZ_WUKV), 128, 768, 768, P.mla_kv_norm + l * 128, gtid, gthreads);
    prep_transpose(P.conv_pw_w + (size_t)l * 256 * 256, reinterpret_cast<bfu*>(P.ws + O_WPW + l * SZ_WPW), 256, 256, 256, nullptr, gtid, gthreads);
    prep_transpose(P.w_out + (size_t)l * 1024 * 1024, reinterpret_cast<bfu*>(P.ws + O_WOUT + l * SZ_WOUT), 1024, 1024, 1024, nullptr, gtid, gthreads);
  }
}

DEVI void hnorm_rows(const float* __restrict__ src, float* __restrict__ xdst, bfu* __restrict__ hdst, const bfu* __restrict__ dsrc,
                     int i0, int istep, int n, const float* __restrict__ modv, const float* __restrict__ g0v, const float* __restrict__ nwp,
                     bool apply_res, int lane) {
  f32x4 A[4], S0[4], G0[4];
#pragma unroll
  for (int i = 0; i < 4; ++i) {
    const int col = (i * 64 + lane) * 4;
    const f32x4 g = *reinterpret_cast<const f32x4*>(nwp + col), s1 = *reinterpret_cast<const f32x4*>(modv + 1024 + col);
    S0[i] = *reinterpret_cast<const f32x4*>(modv + col);
    A[i] = f32x4{g[0] * (1.f + s1[0]), g[1] * (1.f + s1[1]), g[2] * (1.f + s1[2]), g[3] * (1.f + s1[3])};
    G0[i] = apply_res ? *reinterpret_cast<const f32x4*>(g0v + col) : f32x4{0.f, 0.f, 0.f, 0.f};
  }
  f32x4 XA[2][4], XB[2][4]; u32x2 DA[2][4], DB[2][4];
#define LOADSET(X, D, IB) do { _Pragma("unroll") for (int q = 0; q < 2; ++q) { const int idx = (IB) + q * istep; if (idx < n) { \
      _Pragma("unroll") for (int i = 0; i < 4; ++i) X[q][i] = *reinterpret_cast<const f32x4*>(src + (size_t)idx * 1024 + (i * 64 + lane) * 4); \
      if (apply_res) { _Pragma("unroll") for (int i = 0; i < 4; ++i) D[q][i] = *reinterpret_cast<const u32x2*>(dsrc + (size_t)idx * 1024 + (i * 64 + lane) * 4); } } } } while (0)
#define PROCSET(X, D, IB) do { _Pragma("unroll") for (int q = 0; q < 2; ++q) { const int idx = (IB) + q * istep; if (idx < n) { \
      if (apply_res) { _Pragma("unroll") for (int i = 0; i < 4; ++i) { \
          X[q][i][0] += G0[i][0] * bflo(D[q][i][0]); X[q][i][1] += G0[i][1] * bfhi(D[q][i][0]); \
          X[q][i][2] += G0[i][2] * bflo(D[q][i][1]); X[q][i][3] += G0[i][3] * bfhi(D[q][i][1]); \
          *reinterpret_cast<f32x4*>(xdst + (size_t)idx * 1024 + (i * 64 + lane) * 4) = X[q][i]; } } \
      float ss = 0.f; \
      _Pragma("unroll") for (int i = 0; i < 4; ++i) ss += X[q][i][0] * X[q][i][0] + X[q][i][1] * X[q][i][1] + X[q][i][2] * X[q][i][2] + X[q][i][3] * X[q][i][3]; \
      ss = wsum(ss); \
      const float r = rsqrtf(ss * (1.f / 1024.f) + EPS); \
      _Pragma("unroll") for (int i = 0; i < 4; ++i) { \
        const float o0 = X[q][i][0] * r * A[i][0] + S0[i][0], o1 = X[q][i][1] * r * A[i][1] + S0[i][1]; \
        const float o2 = X[q][i][2] * r * A[i][2] + S0[i][2], o3 = X[q][i][3] * r * A[i][3] + S0[i][3]; \
        u32x2 w = {pk2(o0, o1), pk2(o2, o3)}; \
        *reinterpret_cast<u32x2*>(hdst + (size_t)idx * 1024 + (i * 64 + lane) * 4) = w; } } } } while (0)
  int ib = i0;
  LOADSET(XA, DA, ib);
  while (ib < n) {
    LOADSET(XB, DB, ib + 2 * istep);
    PROCSET(XA, DA, ib);
    ib += 2 * istep; if (ib >= n) break;
    LOADSET(XA, DA, ib + 2 * istep);
    PROCSET(XB, DB, ib);
    ib += 2 * istep;
  }
#undef LOADSET
#undef PROCSET
}

DEVI void phase_hnorm(int wv, const Params& P, int layer) {
  const int tid = otid(wv), wid = tid >> 6, lane = tid & 63;
  const int gw = blockIdx.x * (NTHR / 64) + wid, nw = gridDim.x * (NTHR / 64);
  const float* mod = reinterpret_cast<const float*>(P.ws + O_MOD) + (size_t)layer * 9 * 3072;
  const float* mod0 = reinterpret_cast<const float*>(P.ws + O_MOD);
  const float* nwp = P.norm_w + layer * 1024;
  bfu* hb = reinterpret_cast<bfu*>(P.ws + O_H);
  const bfu* dbuf = reinterpret_cast<const bfu*>(P.ws + O_D);
  const bool res = layer == 1;
  {
    const int b = gw & 7;
    const size_t ro = (size_t)b * SEQ * 1024;
    hnorm_rows(P.x + ro, P.out + ro, hb + ro, dbuf + ro, gw >> 3, nw >> 3, SEQ, mod + (size_t)b * 3072, mod0 + (size_t)b * 3072 + 2048, nwp, res, lane);
  }
  {
    const size_t ro = (size_t)ML * 1024;
    hnorm_rows(P.ctx, reinterpret_cast<float*>(P.ws + O_CTX1), hb + ro, dbuf + ro, gw, nw, MC, mod + (size_t)8 * 3072, mod0 + (size_t)8 * 3072 + 2048, nwp, res, lane);
  }
}

constexpr int GROW = 144;
constexpr int G_A_BYTES = 256 * GROW;
constexpr int g_stage(int wn) { return G_A_BYTES + 64 * wn * GROW; }
constexpr int LDS_BYTES = 2 * g_stage(4);
enum { EPI_P = 0, EPI_Q = 1, EPI_KV = 2, EPI_CONV = 3, EPI_OUT = 4 };

struct NextTile { const bfu* A; const bfu* Bt; int lda, ldb, m0, n0; bool valid; };
template <int EPI, int WN>
DEVI void gemm_tile(const bfu* __restrict__ A, int lda, const bfu* __restrict__ Bt, int ldb, int K, int m0, int n0, char* lds, const Params& P, int layer, int tid,
                    u32x4 (&ra)[4], u32x4 (&rb)[WN], bool have_pref, const NextTile& nx) {
  const int wid = tid >> 6, lane = tid & 63, r32 = lane & 31, hi = lane >> 5;
  constexpr int MI = WN, G_STAGE = g_stage(WN);
  const int wm = wid / WN, wn = wid % WN;
  const int srow = tid >> 3, sch = tid & 7;
  const bfu* Ag = A + (size_t)(m0 + srow) * lda + sch * 8;
  const bfu* Bg = Bt + (size_t)(n0 + srow) * ldb + sch * 8;
  f32x16 acc[MI][2];
#pragma unroll
  for (int i = 0; i < MI; ++i)
#pragma unroll
    for (int j = 0; j < 2; ++j)
#pragma unroll
      for (int r = 0; r < 16; ++r) acc[i][j][r] = 0.f;
  const int nk = K / 64;
#define GLOAD(k0) do { _Pragma("unroll") for (int i = 0; i < 4; ++i) ra[i] = *reinterpret_cast<const u32x4*>(Ag + (size_t)(64 * i) * lda + (k0)); \
    _Pragma("unroll") for (int i = 0; i < WN; ++i) rb[i] = *reinterpret_cast<const u32x4*>(Bg + (size_t)(64 * i) * ldb + (k0)); } while (0)
#define LWRITE(buf) do { char* a_ = lds + (buf) * G_STAGE; _Pragma("unroll") for (int i = 0; i < 4; ++i) *reinterpret_cast<u32x4*>(a_ + (srow + 64 * i) * GROW + sch * 16) = ra[i]; \
    char* b_ = a_ + G_A_BYTES; _Pragma("unroll") for (int i = 0; i < WN; ++i) *reinterpret_cast<u32x4*>(b_ + (srow + 64 * i) * GROW + sch * 16) = rb[i]; } while (0)
#define LDFR(kk, B0, B1, AF) do { B0 = *reinterpret_cast<const bf16x8*>(fb + (kk) * 32); B1 = *reinterpret_cast<const bf16x8*>(fb + 32 * GROW + (kk) * 32); \
    _Pragma("unroll") for (int mi = 0; mi < MI; ++mi) AF[mi] = *reinterpret_cast<const bf16x8*>(fa + mi * 32 * GROW + (kk) * 32); } while (0)
#define MM(B0, B1, AF) do { _Pragma("unroll") for (int mi = 0; mi < MI; ++mi) { acc[mi][0] = mfma32(AF[mi], B0, acc[mi][0]); acc[mi][1] = mfma32(AF[mi], B1, acc[mi][1]); } } while (0)
  bf16x8 b0x, b1x, afx[MI], b0y, b1y, afy[MI];
#define PIECE_A(i) do { if (kt + 1 < nk) *reinterpret_cast<u32x4*>(wbase + (srow + 64 * (i)) * GROW + sch * 16) = ra[i]; \
    if (kt + 2 < nk) ra[i] = *reinterpret_cast<const u32x4*>(Ag + (size_t)(64 * (i)) * lda + (kt + 2) * 64); } while (0)
#define PIECE_B(i) do { if (kt + 1 < nk) *reinterpret_cast<u32x4*>(wbase + G_A_BYTES + (srow + 64 * (i)) * GROW + sch * 16) = rb[i]; \
    if (kt + 2 < nk) rb[i] = *reinterpret_cast<const u32x4*>(Bg + (size_t)(64 * (i)) * ldb + (kt + 2) * 64); } while (0)
#define SB_() __builtin_amdgcn_sched_barrier(0)
  if (have_pref) {
#pragma unroll
    for (int i = 0; i < WN; ++i) rb[i] = *reinterpret_cast<const u32x4*>(Bg + (size_t)(64 * i) * ldb);
  } else GLOAD(0);
  LWRITE(0);
  if (1 < nk) GLOAD(64);
  __syncthreads();
  for (int kt = 0; kt < nk; ++kt) {
    const char* fa = lds + (kt & 1) * G_STAGE + (wm * (MI * 32) + r32) * GROW + hi * 16;
    const char* fb = lds + (kt & 1) * G_STAGE + G_A_BYTES + (wn * 64 + r32) * GROW + hi * 16;
    char* wbase = lds + ((kt + 1) & 1) * G_STAGE;
    LDFR(0, b0x, b1x, afx);
    LDFR(1, b0y, b1y, afy);
    SB_(); MM(b0x, b1x, afx); SB_();
    PIECE_A(0); PIECE_A(1);
    LDFR(2, b0x, b1x, afx);
    SB_(); MM(b0y, b1y, afy); SB_();
    PIECE_A(2); PIECE_A(3);
    LDFR(3, b0y, b1y, afy);
    SB_(); MM(b0x, b1x, afx); SB_();
    PIECE_B(0); if constexpr (WN == 4) PIECE_B(1);
    SB_(); MM(b0y, b1y, afy); SB_();
    if constexpr (WN == 4) { PIECE_B(2); PIECE_B(3); } else { PIECE_B(1); }
    __syncthreads();
  }
  if (nx.valid) {
    const bfu* An_ = nx.A + (size_t)(nx.m0 + srow) * nx.lda + sch * 8;
#pragma unroll
    for (int i = 0; i < 4; ++i) ra[i] = *reinterpret_cast<const u32x4*>(An_ + (size_t)(64 * i) * nx.lda);
  }
#undef PIECE_A
#undef PIECE_B
#undef SB_
#undef GLOAD
#undef LWRITE
#undef LDFR
#undef MM
  const bool latent = m0 < ML;
  const int tb_b = latent ? (m0 >> 12) : ((m0 - ML) >> 8), tb_t = latent ? (m0 & 4095) : SEQ;
  bfu* pbuf = reinterpret_cast<bfu*>(P.ws + O_P);
  const float* stats = reinterpret_cast<const float*>(P.ws + O_STATS);
  {
    char* reg = lds + G_STAGE + wid * (32 * GROW);
    const float* rt = reinterpret_cast<const float*>(P.ws + O_ROPE);
    const int cw0 = n0 + wn * 64;
    float cbias[2] = {0.f, 0.f};
    if constexpr (EPI == EPI_CONV) { cbias[0] = P.conv_pw_b[layer * 256 + cw0 + r32]; cbias[1] = P.conv_pw_b[layer * 256 + cw0 + 32 + r32]; }
#pragma unroll
    for (int mi = 0; mi < MI; ++mi) {
      float st[16];
      if constexpr (EPI == EPI_Q || EPI == EPI_KV) {
#pragma unroll
        for (int r = 0; r < 16; ++r) st[r] = stats[(m0 + wm * (MI * 32) + mi * 32 + crow(r, hi)) * 2 + (EPI == EPI_KV ? 1 : 0)];
      }
#pragma unroll
      for (int ni = 0; ni < 2; ++ni) {
        const int nb = cw0 + ni * 32;
        bool rope = false;
        if constexpr (EPI == EPI_Q) rope = latent && ((nb % 96) / 32 == 2) && (nb < 576);
        float cs[16], sn[16];
        if constexpr (EPI == EPI_Q) {
          if (rope) {
            const int sec = r32 >> 4, fi = r32 & 7;
#pragma unroll
            for (int r = 0; r < 16; ++r) {
              const int t = tb_t + wm * (MI * 32) + mi * 32 + crow(r, hi); const int pos = sec ? (t & 63) : (t >> 6);
              cs[r] = rt[pos * 8 + fi]; sn[r] = rt[512 + pos * 8 + fi];
            }
          }
        }
#pragma unroll
        for (int r = 0; r < 16; ++r) {
          float v = acc[mi][ni][r];
          if constexpr (EPI == EPI_Q || EPI == EPI_KV) v *= st[r];
          if constexpr (EPI == EPI_CONV) v += cbias[ni];
          if constexpr (EPI == EPI_Q) {
            if (rope) { const float pn = swz_xor<8>(v); v = !(r32 & 8) ? (v * cs[r] - pn * sn[r]) : (pn * sn[r] + v * cs[r]); }
            v *= QS_M;
          }
          *reinterpret_cast<bfu*>(reg + crow(r, hi) * GROW + (ni * 32 + r32) * 2) = f2bf(v);
        }
      }
#pragma unroll
      for (int i = 0; i < 4; ++i) {
        const int q_ = lane + 64 * i, rr = q_ >> 3, ch = q_ & 7;
        const u32x4 w = *reinterpret_cast<const u32x4*>(reg + rr * GROW + ch * 16);
        const int lr = wm * (MI * 32) + mi * 32 + rr, colc = cw0 + ch * 8;
        if constexpr (EPI == EPI_P) {
          if (colc < INC) *reinterpret_cast<u32x4*>(pbuf + (size_t)(m0 + lr) * INC + colc) = w;
        } else if constexpr (EPI == EPI_Q) {
          if (colc < 576) { const int h = colc / 96, d = colc % 96;
            *reinterpret_cast<u32x4*>(reinterpret_cast<bfu*>(P.ws + O_QM) + ((size_t)(tb_b * 6 + h) * TK + tb_t + lr) * 96 + d) = w; }
        } else if constexpr (EPI == EPI_OUT) {
          *reinterpret_cast<u32x4*>(reinterpret_cast<bfu*>(P.ws + O_D) + (size_t)(m0 + lr) * 1024 + colc) = w;
        } else if constexpr (EPI == EPI_CONV) {
          const u32x4 gw = *reinterpret_cast<const u32x4*>(pbuf + (size_t)(m0 + lr) * INC + PC_GATE + 768 + colc);
          u32x4 o;
#pragma unroll
          for (int j = 0; j < 4; ++j) o[j] = pk2(bflo(w[j]) * siluf(bflo(gw[j])), bfhi(w[j]) * siluf(bfhi(gw[j])));
          *reinterpret_cast<u32x4*>(reinterpret_cast<bfu*>(P.ws + O_H) + (size_t)(m0 + lr) * 1024 + 768 + colc) = o;
        } else {
          const int h = colc >> 7, e = colc & 127;
          bfu* dst = (e < 64) ? reinterpret_cast<bfu*>(P.ws + O_KM) + ((size_t)(tb_b * 6 + h) * TK + tb_t + lr) * 96 + e
                              : reinterpret_cast<bfu*>(P.ws + O_VM) + ((size_t)(tb_b * 6 + h) * TK + tb_t + lr) * 64 + (e - 64);
          *reinterpret_cast<u32x4*>(dst) = w;
        }
      }
    }
  }
}

DEVI void blk_group(int& grp, int& loc, int& per, int& ngrp) {
  const int nb = gridDim.x;
  if ((nb & 7) == 0) { grp = blockIdx.x & 7; loc = blockIdx.x >> 3; per = nb >> 3; ngrp = 8; }
  else { grp = 0; loc = blockIdx.x; per = nb; ngrp = 1; }
}

DEVI void phase_gemm_in(int wv, const Params& P, int layer, bool last, char* lds) {
  const int tid = otid(wv);
  const bfu* A = reinterpret_cast<const bfu*>(P.ws + O_H);
  const bfu* Bt = reinterpret_cast<const bfu*>(P.ws + O_WIN + layer * SZ_WIN);
  constexpr int PANELS = MT / 256, NT = INP / 256;
  int grp, loc, per, ngrp; blk_group(grp, loc, per, ngrp);
  const int PG = PANELS / ngrp, g0 = grp * PG;
  const NextTile none{nullptr, nullptr, 0, 0, 0, 0, false};
  for (int tl = loc; tl < PG * NT; tl += per) {
    const int pm = g0 + tl / NT, pn = tl % NT;
    if (last && pm * 256 >= ML && (pn < 1 || pn > 2)) continue;
    u32x4 ra[4], rb[4];
    gemm_tile<EPI_P, 4>(A, 1024, Bt, 1024, 1024, pm * 256, pn * 256, lds, P, layer, tid, ra, rb, false, none);
  }
}

DEVI void phase_rows(int wv, const Params& P, int layer, bool last, char* lds) {
  const int tid = otid(wv), wid = tid >> 6, lane = tid & 63;
  const int gw = blockIdx.x * (NTHR / 64) + wid, nw = gridDim.x * (NTHR / 64);
  const bfu* pbuf = reinterpret_cast<const bfu*>(P.ws + O_P);
  float* stats = reinterpret_cast<float*>(P.ws + O_STATS);
  const float* rt = reinterpret_cast<const float*>(P.ws + O_ROPE);
  bfu* Km = reinterpret_cast<bfu*>(P.ws + O_KM);
  bfu* Qg = reinterpret_cast<bfu*>(P.ws + O_QG);
  bfu* Kg = reinterpret_cast<bfu*>(P.ws + O_KG);
  bfu* Vg = reinterpret_cast<bfu*>(P.ws + O_VG);
  const float gq = P.gqa_q_norm[layer * 64 + lane], gk = P.gqa_k_norm[layer * 64 + lane];
  for (int row0 = gw; row0 < MT; row0 += 4 * nw) {
    u32x2 wq[4]; unsigned wkv[4]; bfu xq[4][6], xk[4][2], xvv[4][2], xkr[4]; float csg[4], sng[4], c2m[4], s2m[4];
#pragma unroll
    for (int q = 0; q < 4; ++q) {
      const int row = row0 + q * nw;
      if (row < MT) {
        int b, t, v; rowinfo(row, b, t, v);
        const bfu* pr = pbuf + (size_t)row * INC;
        wq[q] = *reinterpret_cast<const u32x2*>(pr + PC_MLAQ + lane * 4);
        wkv[q] = *reinterpret_cast<const unsigned*>(pr + PC_KV + lane * 2);
#pragma unroll
        for (int h = 0; h < 6; ++h) xq[q][h] = pr[PC_GQ + h * 64 + lane];
#pragma unroll
        for (int g = 0; g < 2; ++g) { xk[q][g] = pr[PC_GK + g * 64 + lane]; xvv[q][g] = pr[PC_GV + g * 64 + lane]; }
        xkr[q] = pr[PC_KR + (lane & 31)];
        csg[q] = 1.f; sng[q] = 0.f; c2m[q] = 1.f; s2m[q] = 0.f;
        if (row < ML) {
          { const int sec = lane >> 5, i = lane & 15; const int pos = sec ? (t & 63) : (t >> 6); csg[q] = rt[1024 + pos * 16 + i]; sng[q] = rt[2048 + pos * 16 + i]; }
          { const int e = lane & 31; const int sec = (e >> 4) & 1, i = e & 7; const int pos = sec ? (t & 63) : (t >> 6); c2m[q] = rt[pos * 8 + i]; s2m[q] = rt[512 + pos * 8 + i]; }
        }
      }
    }
#pragma unroll
    for (int q = 0; q < 4; ++q) {
      const int row = row0 + q * nw;
      if (row < MT) {
        int b, t, v; rowinfo(row, b, t, v);
        const bool latent = row < ML;
        {
          float a0 = bflo(wq[q][0]), a1 = bfhi(wq[q][0]), a2 = bflo(wq[q][1]), a3 = bfhi(wq[q][1]);
          float sq = wsum(a0 * a0 + a1 * a1 + a2 * a2 + a3 * a3);
          float c0 = bflo(wkv[q]), c1 = bfhi(wkv[q]);
          float sk = wsum(c0 * c0 + c1 * c1);
          if (lane == 0) { stats[row * 2] = rsqrtf(sq * (1.f / 256.f) + EPS); stats[row * 2 + 1] = rsqrtf(sk * (1.f / 128.f) + EPS); }
        }
        const float cs = csg[q], sn = sng[q];
        const bool firstg = !(lane & 16);
        if (latent || !last) {
#pragma unroll
          for (int h = 0; h < 6; ++h) {
            float x = bf2f(xq[q][h]);
            float ss = wsum(x * x);
            float xn = x * rsqrtf(ss * (1.f / 64.f) + EPS) * gq;
            float pn = swz_xor<16>(xn);
            float o = firstg ? (xn * cs - pn * sn) : (pn * sn + xn * cs);
            Qg[((size_t)(b * 6 + h) * TK + t) * 64 + lane] = f2bf(o * QS_G);
          }
        }
#pragma unroll
        for (int g = 0; g < 2; ++g) {
          float x = bf2f(xk[q][g]);
          float ss = wsum(x * x);
          float xn = x * rsqrtf(ss * (1.f / 64.f) + EPS) * gk;
          float pn = swz_xor<16>(xn);
          float o = firstg ? (xn * cs - pn * sn) : (pn * sn + xn * cs);
          Kg[((size_t)(b * 2 + g) * TK + t) * 64 + lane] = f2bf(o);
          Vg[((size_t)(b * 2 + g) * TK + t) * 64 + lane] = xvv[q][g];
        }
        {
          const int e = lane & 31;
          float x = bf2f(xkr[q]);
          float pn = swz_xor<8>(x);
          float o = !(e & 8) ? (x * c2m[q] - pn * s2m[q]) : (pn * s2m[q] + x * c2m[q]);
          const bfu ob = f2bf(o);
          const int hb = lane >> 5;
#pragma unroll
          for (int hh = 0; hh < 3; ++hh) Km[((size_t)(b * 6 + hh * 2 + hb) * TK + t) * 96 + 64 + e] = ob;
        }
      }
    }
  }
  float* yb = reinterpret_cast<float*>(lds);
  float* ob = yb + 62 * 256;
  bfu* z = reinterpret_cast<bfu*>(P.ws + O_Z);
  const int ntl = NB * 128, ntc = last ? 0 : NB * 8;
  const int c = tid & 255, hf = tid >> 8;
  for (int tile = blockIdx.x; tile < ntl + ntc; tile += gridDim.x) {
    int rowbase, seqlen, t0;
    if (tile < ntl) { const int b = tile >> 7; rowbase = b * SEQ; seqlen = SEQ; t0 = (tile & 127) * 32; }
    else { const int tt = tile - ntl; const int b = tt >> 3; rowbase = ML + b * CTX; seqlen = CTX; t0 = (tt & 7) * 32; }
    __syncthreads();
    for (int idx = tid; idx < 62 * 32; idx += NTHR) {
      const int tr = idx >> 5, ch = idx & 31, tt = t0 - 15 + tr;
      f32x4 o0 = {0.f, 0.f, 0.f, 0.f}, o1 = {0.f, 0.f, 0.f, 0.f};
      if (tt >= 0 && tt < seqlen) {
        const bfu* pr = pbuf + (size_t)(rowbase + tt) * INC + PC_CONV + ch * 8;
        u32x4 a = *reinterpret_cast<const u32x4*>(pr), g = *reinterpret_cast<const u32x4*>(pr + 256);
#pragma unroll
        for (int j = 0; j < 4; ++j) {
          float al = bflo(a[j]), ah = bfhi(a[j]), gl = bflo(g[j]), gh = bfhi(g[j]);
          float yl = al * __builtin_amdgcn_rcpf(1.f + __expf(-gl)), yh = ah * __builtin_amdgcn_rcpf(1.f + __expf(-gh));
          if (j < 2) { o0[j * 2] = yl; o0[j * 2 + 1] = yh; } else { o1[(j - 2) * 2] = yl; o1[(j - 2) * 2 + 1] = yh; }
        }
      }
      *reinterpret_cast<f32x4*>(yb + tr * 256 + ch * 8) = o0;
      *reinterpret_cast<f32x4*>(yb + tr * 256 + ch * 8 + 4) = o1;
    }
    __syncthreads();
    {
      float acc[16];
      const float bias = P.conv_dw_b[layer * 256 + c];
#pragma unroll
      for (int i = 0; i < 16; ++i) acc[i] = bias;
      const float* wp = P.conv_dw_w + (size_t)layer * 31 * 256 + c;
      const float* yp = yb + (hf * 16) * 256 + c;
#pragma unroll
      for (int j = 0; j < 46; ++j) {
        const float yv = yp[j * 256];
#pragma unroll
        for (int i = 0; i < 16; ++i) {
          const int tap = j - i;
          if (tap >= 0 && tap < 31) acc[i] += wp[tap * 256] * yv;
        }
      }
#pragma unroll
      for (int i = 0; i < 16; ++i) ob[(hf * 16 + i) * 256 + c] = acc[i];
    }
    __syncthreads();
    {
      const f32x4 lw = *reinterpret_cast<const f32x4*>(P.conv_ln_w + layer * 256 + lane * 4);
      const f32x4 lb = *reinterpret_cast<const f32x4*>(P.conv_ln_b + layer * 256 + lane * 4);
#pragma unroll
      for (int q = 0; q < 4; ++q) {
        const int tok = wid * 4 + q;
        f32x4 v = *reinterpret_cast<const f32x4*>(ob + tok * 256 + lane * 4);
        const float mu = wsum(v[0] + v[1] + v[2] + v[3]) * (1.f / 256.f);
        const float d0 = v[0] - mu, d1 = v[1] - mu, d2 = v[2] - mu, d3 = v[3] - mu;
        const float var = wsum(d0 * d0 + d1 * d1 + d2 * d2 + d3 * d3) * (1.f / 256.f);
        const float rs = rsqrtf(var + EPS);
        const float n0 = siluf(d0 * rs * lw[0] + lb[0]), n1 = siluf(d1 * rs * lw[1] + lb[1]), n2 = siluf(d2 * rs * lw[2] + lb[2]), n3 = siluf(d3 * rs * lw[3] + lb[3]);
        u32x2 w = {pk2(n0, n1), pk2(n2, n3)};
        *reinterpret_cast<u32x2*>(z + (size_t)(rowbase + t0 + tok) * 256 + lane * 4) = w;
      }
    }
  }
  __syncthreads();
}

DEVI void phase_gemm_mid(int wv, const Params& P, int layer, bool last, char* lds) {
  const int tid = otid(wv);
  const bfu* pbuf = reinterpret_cast<const bfu*>(P.ws + O_P);
  const bfu* Wuq = reinterpret_cast<const bfu*>(P.ws + O_WUQ + layer * SZ_WUQ);
  const bfu* Wukv = reinterpret_cast<const bfu*>(P.ws + O_WUKV + layer * SZ_WUKV);
  const bfu* Wpw = reinterpret_cast<const bfu*>(P.ws + O_WPW + layer * SZ_WPW);
  const bfu* z = reinterpret_cast<const bfu*>(P.ws + O_Z);
  constexpr int PANELS = MT / 256, SUB = 13;
  int grp, loc, per, ngrp; blk_group(grp, loc, per, ngrp);
  const int PG = PANELS / ngrp, g0 = grp * PG;
  const NextTile none{nullptr, nullptr, 0, 0, 0, 0, false};
  for (int tl = loc; tl < PG * SUB; tl += per) {
    const int pm = g0 + tl / SUB, sub = tl % SUB, m0 = pm * 256;
    const bool ctxp = m0 >= ML;
    u32x4 ra[4], rb[2];
    if (sub < 5) { if (!(last && ctxp)) gemm_tile<EPI_Q, 2>(pbuf + PC_MLAQ, INC, Wuq, 256, 256, m0, sub * 128, lds, P, layer, tid, ra, rb, false, none); }
    else if (sub < 11) gemm_tile<EPI_KV, 2>(pbuf + PC_KV, INC, Wukv, 128, 128, m0, (sub - 5) * 128, lds, P, layer, tid, ra, rb, false, none);
    else { if (!(last && ctxp)) gemm_tile<EPI_CONV, 2>(z, 256, Wpw, 256, 256, m0, (sub - 11) * 128, lds, P, layer, tid, ra, rb, false, none); }
  }
}

DEVI int v_st(int k, int c) { return ((k >> 3) * 2 + (c >> 5)) * 512 + ((k & 7) * 32 + (c & 31)) * 2; }
DEVI int v_rd_base(int lane) { return ((lane & 3) << 3) | (((lane >> 2) & 3) << 6) | (((lane >> 4) & 1) << 5) | (((lane >> 5) & 1) << 8); }
constexpr int v_rd_off(int d0, int ks, int half) { return d0 * 512 + ks * 2048 + half * 1024; }
template <int OFF> DEVI s16x4 tr_read(int vb) {
  s16x4 r; asm volatile("ds_read_b64_tr_b16 %0, %1 offset:%2" : "=&v"(r) : "v"(vb), "i"(OFF) : "memory"); return r;
}
#define SBAR() __builtin_amdgcn_sched_barrier(0)

DEVI void pv_all(f32x16& oa, f32x16& ob, int vb, bf16x8 pa0, bf16x8 pa1, bf16x8 pa2, bf16x8 pa3) {
#define PK(L, H) (bf16x8){L[0], L[1], L[2], L[3], H[0], H[1], H[2], H[3]}
  const s16x4 a0 = tr_read<v_rd_off(0, 0, 0)>(vb), b0 = tr_read<v_rd_off(0, 0, 1)>(vb), c0 = tr_read<v_rd_off(1, 0, 0)>(vb), d0 = tr_read<v_rd_off(1, 0, 1)>(vb);
  const s16x4 a1 = tr_read<v_rd_off(0, 1, 0)>(vb), b1 = tr_read<v_rd_off(0, 1, 1)>(vb), c1 = tr_read<v_rd_off(1, 1, 0)>(vb), d1 = tr_read<v_rd_off(1, 1, 1)>(vb);
  const s16x4 a2 = tr_read<v_rd_off(0, 2, 0)>(vb), b2 = tr_read<v_rd_off(0, 2, 1)>(vb), c2 = tr_read<v_rd_off(1, 2, 0)>(vb), d2 = tr_read<v_rd_off(1, 2, 1)>(vb);
  const s16x4 a3 = tr_read<v_rd_off(0, 3, 0)>(vb), b3 = tr_read<v_rd_off(0, 3, 1)>(vb), c3 = tr_read<v_rd_off(1, 3, 0)>(vb), d3 = tr_read<v_rd_off(1, 3, 1)>(vb);
  asm volatile("s_waitcnt lgkmcnt(0)" ::: "memory"); SBAR();
  oa = mfma32(PK(a0, b0), pa0, oa); ob = mfma32(PK(c0, d0), pa0, ob);
  oa = mfma32(PK(a1, b1), pa1, oa); ob = mfma32(PK(c1, d1), pa1, ob);
  oa = mfma32(PK(a2, b2), pa2, oa); ob = mfma32(PK(c2, d2), pa2, ob);
  oa = mfma32(PK(a3, b3), pa3, oa); ob = mfma32(PK(c3, d3), pa3, ob);
#undef PK
}

template <bool FAST> DEVI void partialSM(f32x16& p0, f32x16& p1, float& m_reg, float& alpha) {
  if constexpr (FAST) { alpha = 1.f; return; }
  float pmax = p0[0];
#pragma unroll
  for (int r = 1; r < 16; ++r) pmax = fmaxf(pmax, p0[r]);
#pragma unroll
  for (int r = 0; r < 16; ++r) pmax = fmaxf(pmax, p1[r]);
  { auto rr = __builtin_amdgcn_permlane32_swap(__float_as_uint(pmax), __float_as_uint(pmax), false, false);
    pmax = fmaxf(__uint_as_float(rr[0]), __uint_as_float(rr[1])); }
  if (__all(pmax <= m_reg)) { alpha = 1.f; }
  else { const float mn = fmaxf(m_reg, pmax); alpha = __builtin_amdgcn_exp2f(m_reg - mn); m_reg = mn; }
#pragma unroll
  for (int r = 0; r < 16; ++r) p0[r] = __builtin_amdgcn_exp2f(p0[r] - m_reg);
#pragma unroll
  for (int r = 0; r < 16; ++r) p1[r] = p1[r] - m_reg;
}
template <bool FAST> DEVI void finishSM(f32x16& p0, f32x16& p1, float alpha, float& l_reg, bf16x8& pa0, bf16x8& pa1, bf16x8& pa2, bf16x8& pa3) {
  if constexpr (FAST) {
#pragma unroll
    for (int r = 0; r < 16; ++r) p0[r] = __builtin_amdgcn_exp2f(p0[r]);
  }
#pragma unroll
  for (int r = 0; r < 16; ++r) p1[r] = __builtin_amdgcn_exp2f(p1[r]);
  float ps = 0.f;
#pragma unroll
  for (int r = 0; r < 16; ++r) ps += p0[r];
#pragma unroll
  for (int r = 0; r < 16; ++r) ps += p1[r];
  if constexpr (FAST) { l_reg += ps; }
  else {
  { auto rr = __builtin_amdgcn_permlane32_swap(__float_as_uint(ps), __float_as_uint(ps), false, false);
    ps = __uint_as_float(rr[0]) + __uint_as_float(rr[1]); }
  l_reg = l_reg * alpha + ps;
  }
#define PK8(P, BASE, OUT) do { u32x4 w = {cvtpk(P[BASE + 0], P[BASE + 1]), cvtpk(P[BASE + 2], P[BASE + 3]), cvtpk(P[BASE + 4], P[BASE + 5]), cvtpk(P[BASE + 6], P[BASE + 7])}; \
    OUT = *reinterpret_cast<bf16x8*>(&w); } while (0)
  PK8(p0, 0, pa0); PK8(p0, 8, pa1); PK8(p1, 0, pa2); PK8(p1, 8, pa3);
#undef PK8
}

template <int DQK>
DEVI void qkt(f32x16& p0, f32x16& p1, const char* Ks, const bf16x8* qr, int r32, int hi) {
  constexpr int KROW = DQK * 2 + 16, ND = DQK / 16;
#pragma unroll
  for (int r = 0; r < 16; ++r) { p0[r] = 0.f; p1[r] = 0.f; }
  const char* ka = Ks + r32 * KROW + hi * 16;
  const char* kb = Ks + (32 + r32) * KROW + hi * 16;
  bf16x8 x0 = *reinterpret_cast<const bf16x8*>(ka), x1 = *reinterpret_cast<const bf16x8*>(kb), y0, y1;
#pragma unroll
  for (int d0 = 0; d0 < ND; d0 += 2) {
    if (d0 + 1 < ND) { y0 = *reinterpret_cast<const bf16x8*>(ka + (d0 + 1) * 32); y1 = *reinterpret_cast<const bf16x8*>(kb + (d0 + 1) * 32); }
    SBAR();
    p0 = mfma32(x0, qr[d0], p0); p1 = mfma32(x1, qr[d0], p1);
    SBAR();
    if (d0 + 1 < ND) {
      if (d0 + 2 < ND) { x0 = *reinterpret_cast<const bf16x8*>(ka + (d0 + 2) * 32); x1 = *reinterpret_cast<const bf16x8*>(kb + (d0 + 2) * 32); }
      SBAR();
      p0 = mfma32(y0, qr[d0 + 1], p0); p1 = mfma32(y1, qr[d0 + 1], p1);
      SBAR();
    }
  }
}

template <int DQK, bool FAST>
DEVI bool attn_unit(const bfu* __restrict__ Q, const bfu* __restrict__ Kh, const bfu* __restrict__ Vh, int nkeys,
                    const bfu* __restrict__ pg, bfu* __restrict__ yo, char* lds, int tid) {
  constexpr int KROW = DQK * 2 + 16, KT_BYTES = 64 * KROW, VT_BYTES = 8192, KCH = 64 * (DQK / 8);
  constexpr int CPR = DQK / 8;
  const int wid = tid >> 6, lane = tid & 63, r32 = lane & 31, hi = lane >> 5;
  char* K_lds = lds; char* V_lds = lds + 3 * KT_BYTES;
  float m_reg = -1e30f, l_reg = 0.f;
  f32x16 o0, o1;
#pragma unroll
  for (int r = 0; r < 16; ++r) { o0[r] = 0.f; o1[r] = 0.f; }
  bf16x8 qr[DQK / 16];
  {
    const bfu* Qw = Q + (size_t)(wid * 32 + r32) * DQK + hi * 8;
#pragma unroll
    for (int d0 = 0; d0 < DQK / 16; ++d0) qr[d0] = *reinterpret_cast<const bf16x8*>(Qw + d0 * 16);
  }
  const bool k2 = (tid + 512) < KCH;
  const int kq0 = tid, kq1 = tid + 512;
  const int kst0 = (kq0 / CPR) * KROW + (kq0 % CPR) * 16, kst1 = (kq1 / CPR) * KROW + (kq1 % CPR) * 16;
  const int vst = v_st(tid >> 3, (tid & 7) * 8);
  const int vb0 = (int)(uintptr_t)V_lds + v_rd_base(lane);
  u32x4 sk0, sk1, sv;
  sk1 = u32x4{0u, 0u, 0u, 0u};
#define SLOAD(kt) do { const bfu* kp_ = Kh + (size_t)(kt) * 64 * DQK; sk0 = *reinterpret_cast<const u32x4*>(kp_ + kq0 * 8); \
    if (k2) sk1 = *reinterpret_cast<const u32x4*>(kp_ + kq1 * 8); sv = *reinterpret_cast<const u32x4*>(Vh + (size_t)(kt) * 64 * 64 + tid * 8); } while (0)
#define SWRITE(s) do { *reinterpret_cast<u32x4*>(K_lds + (s) * KT_BYTES + kst0) = sk0; if (k2) *reinterpret_cast<u32x4*>(K_lds + (s) * KT_BYTES + kst1) = sk1; \
    *reinterpret_cast<u32x4*>(V_lds + (s) * VT_BYTES + vst) = sv; } while (0)
#define RESC(a) do { if constexpr (!FAST) if (__any((a) < 1.f)) { _Pragma("unroll") for (int r = 0; r < 16; ++r) { o0[r] *= (a); o1[r] *= (a); } } } while (0)
  f32x16 pA0, pA1, pB0, pB1; float alA, alB; bf16x8 pa0, pa1, pa2, pa3;
  const int NT = nkeys / 64;
  __syncthreads();
  SLOAD(0); SWRITE(0); SLOAD(1);
  __syncthreads();
  SWRITE(1); SLOAD(2);
  qkt<DQK>(pA0, pA1, K_lds, qr, r32, hi); partialSM<FAST>(pA0, pA1, m_reg, alA);
  __syncthreads();
  int sa = 0, sb = 1, sc = 2;
  for (int j = 1; j + 1 < NT; j += 2) {
    SWRITE(sc); if (j + 2 < NT) SLOAD(j + 2);
    SBAR(); qkt<DQK>(pB0, pB1, K_lds + sb * KT_BYTES, qr, r32, hi); if constexpr (FAST) SBAR();
    finishSM<FAST>(pA0, pA1, alA, l_reg, pa0, pa1, pa2, pa3); SBAR();
    pv_all(o0, o1, vb0 + sa * VT_BYTES, pa0, pa1, pa2, pa3);
    partialSM<FAST>(pB0, pB1, m_reg, alB); RESC(alB);
    __syncthreads();
    SWRITE(sa); if (j + 3 < NT) SLOAD(j + 3);
    SBAR(); qkt<DQK>(pA0, pA1, K_lds + sc * KT_BYTES, qr, r32, hi); if constexpr (FAST) SBAR();
    finishSM<FAST>(pB0, pB1, alB, l_reg, pa0, pa1, pa2, pa3); SBAR();
    pv_all(o0, o1, vb0 + sb * VT_BYTES, pa0, pa1, pa2, pa3);
    partialSM<FAST>(pA0, pA1, m_reg, alA); RESC(alA);
    __syncthreads();
    { const int t_ = sa; sa = sc; sc = sb; sb = t_; }
  }
  SBAR(); qkt<DQK>(pB0, pB1, K_lds + sb * KT_BYTES, qr, r32, hi);
  finishSM<FAST>(pA0, pA1, alA, l_reg, pa0, pa1, pa2, pa3); SBAR();
  pv_all(o0, o1, vb0 + sa * VT_BYTES, pa0, pa1, pa2, pa3);
  partialSM<FAST>(pB0, pB1, m_reg, alB); RESC(alB);
  finishSM<FAST>(pB0, pB1, alB, l_reg, pa0, pa1, pa2, pa3); SBAR();
  pv_all(o0, o1, vb0 + sb * VT_BYTES, pa0, pa1, pa2, pa3);
#undef SLOAD
#undef SWRITE
#undef RESC
  if constexpr (FAST) {
    { auto rr = __builtin_amdgcn_permlane32_swap(__float_as_uint(l_reg), __float_as_uint(l_reg), false, false);
      l_reg = __uint_as_float(rr[0]) + __uint_as_float(rr[1]); }
    const int bad = !(l_reg > 1e-30f && l_reg < 1e30f);
    const int wbad = __any(bad) ? 1 : 0;
    __syncthreads();
    if (lane == 0) reinterpret_cast<int*>(lds)[wid] = wbad;
    __syncthreads();
    int anyb = 0;
#pragma unroll
    for (int w = 0; w < NTHR / 64; ++w) anyb |= reinterpret_cast<const int*>(lds)[w];
    if (anyb) return false;
  }
  const float inv = 1.f / l_reg;
  const int qrow = wid * 32 + r32;
  const bfu* pgr = pg + (size_t)qrow * INC;
  bfu* yr = yo + (size_t)qrow * 1024;
#pragma unroll
  for (int g4 = 0; g4 < 4; ++g4) {
    const int cbase = 8 * g4 + 4 * hi;
    {
      u32x2 gw = *reinterpret_cast<const u32x2*>(pgr + cbase);
      float a0 = o0[g4 * 4 + 0] * inv * siluf(bflo(gw[0])), a1 = o0[g4 * 4 + 1] * inv * siluf(bfhi(gw[0]));
      float a2 = o0[g4 * 4 + 2] * inv * siluf(bflo(gw[1])), a3 = o0[g4 * 4 + 3] * inv * siluf(bfhi(gw[1]));
      u32x2 w = {pk2(a0, a1), pk2(a2, a3)};
      *reinterpret_cast<u32x2*>(yr + cbase) = w;
    }
    {
      u32x2 gw = *reinterpret_cast<const u32x2*>(pgr + 32 + cbase);
      float a0 = o1[g4 * 4 + 0] * inv * siluf(bflo(gw[0])), a1 = o1[g4 * 4 + 1] * inv * siluf(bfhi(gw[0]));
      float a2 = o1[g4 * 4 + 2] * inv * siluf(bflo(gw[1])), a3 = o1[g4 * 4 + 3] * inv * siluf(bfhi(gw[1]));
      u32x2 w = {pk2(a0, a1), pk2(a2, a3)};
      *reinterpret_cast<u32x2*>(yr + 32 + cbase) = w;
    }
  }
  return true;
}

template <int DQK>
DEVI bool attn_unit_w128(const bfu* __restrict__ Q, const bfu* __restrict__ Kh, const bfu* __restrict__ Vh, int nkeys,
                         const bfu* __restrict__ pg, bfu* __restrict__ yo, char* lds, int tid) {
  constexpr int KROW = DQK * 2 + 16, KT_BYTES = 128 * KROW, VT_BYTES = 16384, CPR = DQK / 8, NKC = 128 * CPR / NTHR;
  const int wid = tid >> 6, lane = tid & 63, r32 = lane & 31, hi = lane >> 5;
  char* K_lds = lds; char* V_lds = lds + 2 * KT_BYTES;
  float l_reg = 0.f;
  f32x16 o0, o1;
#pragma unroll
  for (int r = 0; r < 16; ++r) { o0[r] = 0.f; o1[r] = 0.f; }
  bf16x8 qr[DQK / 16];
  {
    const bfu* Qw = Q + (size_t)(wid * 32 + r32) * DQK + hi * 8;
#pragma unroll
    for (int d0 = 0; d0 < DQK / 16; ++d0) qr[d0] = *reinterpret_cast<const bf16x8*>(Qw + d0 * 16);
  }
  int kst[NKC];
#pragma unroll
  for (int i = 0; i < NKC; ++i) { const int q_ = tid + i * NTHR; kst[i] = (q_ / CPR) * KROW + (q_ % CPR) * 16; }
  const int vst0 = v_st(tid >> 3, (tid & 7) * 8), vst1 = v_st(64 + (tid >> 3), (tid & 7) * 8);
  const int vb0 = (int)(uintptr_t)V_lds + v_rd_base(lane);
  u32x4 sk[NKC], sv0, sv1;
#define SLOAD(kt) do { const bfu* kp_ = Kh + (size_t)(kt) * 128 * DQK + tid * 8; _Pragma("unroll") for (int i = 0; i < NKC; ++i) sk[i] = *reinterpret_cast<const u32x4*>(kp_ + i * NTHR * 8); \
    const bfu* vp_ = Vh + (size_t)(kt) * 128 * 64 + tid * 8; sv0 = *reinterpret_cast<const u32x4*>(vp_); sv1 = *reinterpret_cast<const u32x4*>(vp_ + NTHR * 8); } while (0)
#define SWRITE(s) do { _Pragma("unroll") for (int i = 0; i < NKC; ++i) *reinterpret_cast<u32x4*>(K_lds + (s) * KT_BYTES + kst[i]) = sk[i]; \
    *reinterpret_cast<u32x4*>(V_lds + (s) * VT_BYTES + vst0) = sv0; *reinterpret_cast<u32x4*>(V_lds + (s) * VT_BYTES + vst1) = sv1; } while (0)
  const int NT = nkeys / 128;
  float m_dummy = 0.f, al_dummy = 1.f;
  __syncthreads();
  SLOAD(0); SWRITE(0);
  if (1 < NT) SLOAD(1);
  __syncthreads();
  for (int j = 0; j < NT; ++j) {
    const int sl = j & 1;
    if (j + 1 < NT) SWRITE(sl ^ 1);
    if (j + 2 < NT) SLOAD(j + 2);
    f32x16 p0, p1, p2, p3; bf16x8 pa0, pa1, pa2, pa3, pb0, pb1, pb2, pb3;
    qkt<DQK>(p0, p1, K_lds + sl * KT_BYTES, qr, r32, hi);
    qkt<DQK>(p2, p3, K_lds + sl * KT_BYTES + 64 * KROW, qr, r32, hi);
    finishSM<true>(p0, p1, al_dummy, l_reg, pa0, pa1, pa2, pa3);
    finishSM<true>(p2, p3, al_dummy, l_reg, pb0, pb1, pb2, pb3);
    SBAR();
    pv_all(o0, o1, vb0 + sl * VT_BYTES, pa0, pa1, pa2, pa3);
    pv_all(o0, o1, vb0 + sl * VT_BYTES + 8192, pb0, pb1, pb2, pb3);
    __syncthreads();
  }
#undef SLOAD
#undef SWRITE
  (void)m_dummy;
  { auto rr = __builtin_amdgcn_permlane32_swap(__float_as_uint(l_reg), __float_as_uint(l_reg), false, false);
    l_reg = __uint_as_float(rr[0]) + __uint_as_float(rr[1]); }
  {
    const int bad = !(l_reg > 1e-30f && l_reg < 1e30f);
    const int wbad = __any(bad) ? 1 : 0;
    __syncthreads();
    if (lane == 0) reinterpret_cast<int*>(lds)[wid] = wbad;
    __syncthreads();
    int anyb = 0;
#pragma unroll
    for (int w = 0; w < NTHR / 64; ++w) anyb |= reinterpret_cast<const int*>(lds)[w];
    if (anyb) return false;
  }
  const float inv = 1.f / l_reg;
  const int qrow = wid * 32 + r32;
  const bfu* pgr = pg + (size_t)qrow * INC;
  bfu* yr = yo + (size_t)qrow * 1024;
#pragma unroll
  for (int g4 = 0; g4 < 4; ++g4) {
    const int cbase = 8 * g4 + 4 * hi;
    {
      u32x2 gw = *reinterpret_cast<const u32x2*>(pgr + cbase);
      float a0 = o0[g4 * 4 + 0] * inv * siluf(bflo(gw[0])), a1 = o0[g4 * 4 + 1] * inv * siluf(bfhi(gw[0]));
      float a2 = o0[g4 * 4 + 2] * inv * siluf(bflo(gw[1])), a3 = o0[g4 * 4 + 3] * inv * siluf(bfhi(gw[1]));
      u32x2 w = {pk2(a0, a1), pk2(a2, a3)};
      *reinterpret_cast<u32x2*>(yr + cbase) = w;
    }
    {
      u32x2 gw = *reinterpret_cast<const u32x2*>(pgr + 32 + cbase);
      float a0 = o1[g4 * 4 + 0] * inv * siluf(bflo(gw[0])), a1 = o1[g4 * 4 + 1] * inv * siluf(bfhi(gw[0]));
      float a2 = o1[g4 * 4 + 2] * inv * siluf(bflo(gw[1])), a3 = o1[g4 * 4 + 3] * inv * siluf(bfhi(gw[1]));
      u32x2 w = {pk2(a0, a1), pk2(a2, a3)};
      *reinterpret_cast<u32x2*>(yr + 32 + cbase) = w;
    }
  }
  return true;
}

template <int DQK>
DEVI bool attn_unit_ks(const bfu* __restrict__ Q, const bfu* __restrict__ Kh, const bfu* __restrict__ Vh, int nkeys,
                       const bfu* __restrict__ pg, bfu* __restrict__ yo, char* lds, int tid) {
  constexpr int KROW = DQK * 2 + 16, KT_BYTES = 64 * KROW, VT_BYTES = 8192, KCH = 64 * (DQK / 8), CPR = DQK / 8, ND = DQK / 16;
  const int wid = tid >> 6, lane = tid & 63, r32 = lane & 31, hi = lane >> 5;
  const int qg = wid >> 1, kh = wid & 1;
  char* K_lds = lds; char* V_lds = lds + 3 * KT_BYTES;
  float l0 = 0.f, l1 = 0.f;
  f32x16 o00, o01, o10, o11;
#pragma unroll
  for (int r = 0; r < 16; ++r) { o00[r] = 0.f; o01[r] = 0.f; o10[r] = 0.f; o11[r] = 0.f; }
  bf16x8 qa[ND], qb[ND];
  {
    const bfu* Qw = Q + (size_t)(qg * 64 + r32) * DQK + hi * 8;
#pragma unroll
    for (int d0 = 0; d0 < ND; ++d0) { qa[d0] = *reinterpret_cast<const bf16x8*>(Qw + d0 * 16); qb[d0] = *reinterpret_cast<const bf16x8*>(Qw + 32 * DQK + d0 * 16); }
  }
  const bool k2 = (tid + 512) < KCH;
  const int kq0 = tid, kq1 = tid + 512;
  const int kst0 = (kq0 / CPR) * KROW + (kq0 % CPR) * 16, kst1 = (kq1 / CPR) * KROW + (kq1 % CPR) * 16;
  const int vst = v_st(tid >> 3, (tid & 7) * 8);
  const int vb0 = (int)(uintptr_t)V_lds + kh * 4096 + v_rd_base(lane);
  const int kfo = (kh * 32 + r32) * KROW + hi * 16;
  u32x4 sk0, sk1, sv;
  sk1 = u32x4{0u, 0u, 0u, 0u};
  const unsigned ko0 = (unsigned)kq0 * 16u, ko1 = (unsigned)kq1 * 16u, vo0 = (unsigned)tid * 16u;
#define SLOAD(kt) do { const char* kp_ = reinterpret_cast<const char*>(Kh) + (size_t)(kt) * (64 * DQK * 2); sk0 = *reinterpret_cast<const u32x4*>(kp_ + ko0); \
    if (k2) sk1 = *reinterpret_cast<const u32x4*>(kp_ + ko1); sv = *reinterpret_cast<const u32x4*>(reinterpret_cast<const char*>(Vh) + (size_t)(kt) * (64 * 64 * 2) + vo0); } while (0)
#define SWRITE(s) do { *reinterpret_cast<u32x4*>(K_lds + (s) * KT_BYTES + kst0) = sk0; if (k2) *reinterpret_cast<u32x4*>(K_lds + (s) * KT_BYTES + kst1) = sk1; \
    *reinterpret_cast<u32x4*>(V_lds + (s) * VT_BYTES + vst) = sv; } while (0)
  const int NT = nkeys / 64;
  __syncthreads();
  SLOAD(0); SWRITE(0); SLOAD(1);
  __syncthreads();
  int slot = 0, wslot = 1;
  for (int j = 0; j < NT; ++j) {
    if (j + 1 < NT) SWRITE(wslot);
    if (j + 2 < NT) SLOAD(j + 2);
    f32x16 pA, pB;
#pragma unroll
    for (int r = 0; r < 16; ++r) { pA[r] = 0.f; pB[r] = 0.f; }
    {
      const char* kp = K_lds + slot * KT_BYTES + kfo;
#pragma unroll
      for (int d0 = 0; d0 < ND; ++d0) {
        const bf16x8 kx = *reinterpret_cast<const bf16x8*>(kp + d0 * 32);
        pA = mfma32(kx, qa[d0], pA); pB = mfma32(kx, qb[d0], pB);
      }
    }
    float psA = 0.f, psB = 0.f;
#pragma unroll
    for (int r = 0; r < 16; ++r) { pA[r] = __builtin_amdgcn_exp2f(pA[r]); pB[r] = __builtin_amdgcn_exp2f(pB[r]); }
#pragma unroll
    for (int r = 0; r < 16; ++r) { psA += pA[r]; psB += pB[r]; }
    l0 += psA; l1 += psB;
    bf16x8 fA0, fA1, fB0, fB1;
#define PK8(P, BASE, OUT) do { u32x4 w = {cvtpk(P[BASE + 0], P[BASE + 1]), cvtpk(P[BASE + 2], P[BASE + 3]), cvtpk(P[BASE + 4], P[BASE + 5]), cvtpk(P[BASE + 6], P[BASE + 7])}; \
    OUT = *reinterpret_cast<bf16x8*>(&w); } while (0)
    PK8(pA, 0, fA0); PK8(pA, 8, fA1); PK8(pB, 0, fB0); PK8(pB, 8, fB1);
#undef PK8
    SBAR();
    {
      const int vb = vb0 + slot * VT_BYTES;
#define PK(L, H) (bf16x8){L[0], L[1], L[2], L[3], H[0], H[1], H[2], H[3]}
      {
        const s16x4 a0 = tr_read<v_rd_off(0, 0, 0)>(vb), b0 = tr_read<v_rd_off(0, 0, 1)>(vb), c0 = tr_read<v_rd_off(1, 0, 0)>(vb), d0_ = tr_read<v_rd_off(1, 0, 1)>(vb);
        asm volatile("s_waitcnt lgkmcnt(0)" ::: "memory"); SBAR();
        const bf16x8 v00 = PK(a0, b0), v10 = PK(c0, d0_);
        o00 = mfma32(v00, fA0, o00); o01 = mfma32(v10, fA0, o01); o10 = mfma32(v00, fB0, o10); o11 = mfma32(v10, fB0, o11);
      }
      SBAR();
      {
        const s16x4 a1 = tr_read<v_rd_off(0, 1, 0)>(vb), b1 = tr_read<v_rd_off(0, 1, 1)>(vb), c1 = tr_read<v_rd_off(1, 1, 0)>(vb), d1_ = tr_read<v_rd_off(1, 1, 1)>(vb);
        asm volatile("s_waitcnt lgkmcnt(0)" ::: "memory"); SBAR();
        const bf16x8 v01 = PK(a1, b1), v11 = PK(c1, d1_);
        o00 = mfma32(v01, fA1, o00); o01 = mfma32(v11, fA1, o01); o10 = mfma32(v01, fB1, o10); o11 = mfma32(v11, fB1, o11);
      }
#undef PK
    }
    __syncthreads();
    slot = (slot == 2) ? 0 : slot + 1; wslot = (wslot == 2) ? 0 : wslot + 1;
  }
#undef SLOAD
#undef SWRITE
  float* cbuf = reinterpret_cast<float*>(lds);
  float* mine = cbuf + wid * (33 * 64) + lane;
  const float* theirs = cbuf + (wid ^ 1) * (33 * 64) + lane;
  f32x16 o0, o1; float l_reg;
  if (kh) {
#pragma unroll
    for (int r = 0; r < 16; ++r) { mine[r * 64] = o00[r]; mine[(16 + r) * 64] = o01[r]; }
    mine[32 * 64] = l0;
    o0 = o10; o1 = o11; l_reg = l1;
  } else {
#pragma unroll
    for (int r = 0; r < 16; ++r) { mine[r * 64] = o10[r]; mine[(16 + r) * 64] = o11[r]; }
    mine[32 * 64] = l1;
    o0 = o00; o1 = o01; l_reg = l0;
  }
  __syncthreads();
#pragma unroll
  for (int r = 0; r < 16; ++r) { o0[r] += theirs[r * 64]; o1[r] += theirs[(16 + r) * 64]; }
  l_reg += theirs[32 * 64];
  { auto rr = __builtin_amdgcn_permlane32_swap(__float_as_uint(l_reg), __float_as_uint(l_reg), false, false);
    l_reg = __uint_as_float(rr[0]) + __uint_as_float(rr[1]); }
  {
    const int bad = !(l_reg > 1e-30f && l_reg < 1e30f);
    const int wbad = __any(bad) ? 1 : 0;
    __syncthreads();
    if (lane == 0) reinterpret_cast<int*>(lds)[wid] = wbad;
    __syncthreads();
    int anyb = 0;
#pragma unroll
    for (int w = 0; w < NTHR / 64; ++w) anyb |= reinterpret_cast<const int*>(lds)[w];
    if (anyb) return false;
  }
  const float inv = 1.f / l_reg;
  const int qrow = qg * 64 + kh * 32 + r32;
  const bfu* pgr = pg + (size_t)qrow * INC;
  bfu* yr = yo + (size_t)qrow * 1024;
#pragma unroll
  for (int g4 = 0; g4 < 4; ++g4) {
    const int cbase = 8 * g4 + 4 * hi;
    {
      u32x2 gw = *reinterpret_cast<const u32x2*>(pgr + cbase);
      float a0 = o0[g4 * 4 + 0] * inv * siluf(bflo(gw[0])), a1 = o0[g4 * 4 + 1] * inv * siluf(bfhi(gw[0]));
      float a2 = o0[g4 * 4 + 2] * inv * siluf(bflo(gw[1])), a3 = o0[g4 * 4 + 3] * inv * siluf(bfhi(gw[1]));
      u32x2 w = {pk2(a0, a1), pk2(a2, a3)};
      *reinterpret_cast<u32x2*>(yr + cbase) = w;
    }
    {
      u32x2 gw = *reinterpret_cast<const u32x2*>(pgr + 32 + cbase);
      float a0 = o1[g4 * 4 + 0] * inv * siluf(bflo(gw[0])), a1 = o1[g4 * 4 + 1] * inv * siluf(bfhi(gw[0]));
      float a2 = o1[g4 * 4 + 2] * inv * siluf(bflo(gw[1])), a3 = o1[g4 * 4 + 3] * inv * siluf(bfhi(gw[1]));
      u32x2 w = {pk2(a0, a1), pk2(a2, a3)};
      *reinterpret_cast<u32x2*>(yr + 32 + cbase) = w;
    }
  }
  return true;
}

template <bool FAST> DEVI bool attn_dispatch(const Params& P, int b, int head12, int qb, bool ctxq, char* lds, int tid) {
  const bfu* pbuf = reinterpret_cast<const bfu*>(P.ws + O_P);
  bfu* yb = reinterpret_cast<bfu*>(P.ws + O_H);
  const int t0 = ctxq ? SEQ : qb * 256;
  const int row0 = ctxq ? ML + b * CTX : b * SEQ + qb * 256;
  const int kt0 = ctxq ? SEQ : 0, nkeys = ctxq ? CTX : TK;
  if (head12 < 6) {
    const int h = head12;
    const bfu* Q = reinterpret_cast<const bfu*>(P.ws + O_QM) + ((size_t)(b * 6 + h) * TK + t0) * 96;
    const bfu* K = reinterpret_cast<const bfu*>(P.ws + O_KM) + ((size_t)(b * 6 + h) * TK + kt0) * 96;
    const bfu* V = reinterpret_cast<const bfu*>(P.ws + O_VM) + ((size_t)(b * 6 + h) * TK + kt0) * 64;
    if constexpr (FAST) return attn_unit_w128<96>(Q, K, V, nkeys, pbuf + (size_t)row0 * INC + PC_GATE + h * 64, yb + (size_t)row0 * 1024 + h * 64, lds, tid);
    else return attn_unit<96, false>(Q, K, V, nkeys, pbuf + (size_t)row0 * INC + PC_GATE + h * 64, yb + (size_t)row0 * 1024 + h * 64, lds, tid);
  } else {
    const int h = head12 - 6, g = h / 3;
    const bfu* Q = reinterpret_cast<const bfu*>(P.ws + O_QG) + ((size_t)(b * 6 + h) * TK + t0) * 64;
    const bfu* K = reinterpret_cast<const bfu*>(P.ws + O_KG) + ((size_t)(b * 2 + g) * TK + kt0) * 64;
    const bfu* V = reinterpret_cast<const bfu*>(P.ws + O_VG) + ((size_t)(b * 2 + g) * TK + kt0) * 64;
    if constexpr (FAST) return attn_unit_w128<64>(Q, K, V, nkeys, pbuf + (size_t)row0 * INC + PC_GATE + 384 + h * 64, yb + (size_t)row0 * 1024 + 384 + h * 64, lds, tid);
    else return attn_unit<64, false>(Q, K, V, nkeys, pbuf + (size_t)row0 * INC + PC_GATE + 384 + h * 64, yb + (size_t)row0 * 1024 + 384 + h * 64, lds, tid);
  }
}

template <bool FAST> DEVI unsigned phase_attn(int wv, const Params& P, bool last, char* lds, unsigned mask) {
  const int tid = otid(wv);
  int grp, loc, per, ngrp; blk_group(grp, loc, per, ngrp);
  const int UL = (NB / ngrp) * 192, UC = last ? 0 : (NB / ngrp) * 12;
  unsigned bad = 0u; int k = 0;
  for (int u = loc; u < UL + UC; u += per, ++k) {
    if (!FAST && !((mask >> (k & 31)) & 1u)) continue;
    bool ok;
    if (u < UL) { const int ug = grp * UL + u; ok = attn_dispatch<FAST>(P, ug / 192, (ug % 192) >> 4, ug & 15, false, lds, tid); }
    else { const int ug = grp * UC + (u - UL); ok = attn_dispatch<FAST>(P, ug / 12, ug % 12, 0, true, lds, tid); }
    if (!ok) bad |= 1u << (k & 31);
  }
  return bad;
}

DEVI void phase_gemm_out(int wv, const Params& P, int layer, bool last, char* lds) {
  const int tid = otid(wv);
  const bfu* A = reinterpret_cast<const bfu*>(P.ws + O_H);
  const bfu* Bt = reinterpret_cast<const bfu*>(P.ws + O_WOUT + layer * SZ_WOUT);
  const int PANELS = last ? ML / 256 : MT / 256;
  constexpr int NT = 8;
  int grp, loc, per, ngrp; blk_group(grp, loc, per, ngrp);
  const int PG = PANELS / ngrp, g0 = grp * PG;
  u32x4 ra[4], rb[2]; bool pref = false;
  for (int tl = loc; tl < PG * NT; tl += per) {
    const int tn = tl + per;
    NextTile nx{A, Bt, 1024, 1024, (g0 + tn / NT) * 256, (tn % NT) * 128, tn < PG * NT};
    gemm_tile<EPI_OUT, 2>(A, 1024, Bt, 1024, 1024, (g0 + tl / NT) * 256, (tl % NT) * 128, lds, P, layer, tid, ra, rb, pref, nx);
    pref = nx.valid;
  }
}

DEVI void phase_final(int wv, const Params& P) {
  const int tid = otid(wv), wid = tid >> 6, lane = tid & 63;
  const int gw = blockIdx.x * (NTHR / 64) + wid, nw = gridDim.x * (NTHR / 64);
  const int b = gw & 7, i0 = gw >> 3, istep = nw >> 3;
  const size_t ro = (size_t)b * SEQ * 1024;
  float* xo = P.out + ro;
  const bfu* dsrc = reinterpret_cast<const bfu*>(P.ws + O_D) + ro;
  const float* g1v = reinterpret_cast<const float*>(P.ws + O_MOD) + (size_t)9 * 3072 + (size_t)b * 3072 + 2048;
  f32x4 GW[4], G1[4];
#pragma unroll
  for (int i = 0; i < 4; ++i) { GW[i] = *reinterpret_cast<const f32x4*>(P.final_norm_w + (i * 64 + lane) * 4); G1[i] = *reinterpret_cast<const f32x4*>(g1v + (i * 64 + lane) * 4); }
  f32x4 XA[2][4], XB[2][4]; u32x2 DA[2][4], DB[2][4];
#define LOADSET(X, D, IB) do { _Pragma("unroll") for (int q = 0; q < 2; ++q) { const int idx = (IB) + q * istep; if (idx < SEQ) { \
      _Pragma("unroll") for (int i = 0; i < 4; ++i) { X[q][i] = *reinterpret_cast<const f32x4*>(xo + (size_t)idx * 1024 + (i * 64 + lane) * 4); \
        D[q][i] = *reinterpret_cast<const u32x2*>(dsrc + (size_t)idx * 1024 + (i * 64 + lane) * 4); } } } } while (0)
#define PROCSET(X, D, IB) do { _Pragma("unroll") for (int q = 0; q < 2; ++q) { const int idx = (IB) + q * istep; if (idx < SEQ) { \
      float ss = 0.f; \
      _Pragma("unroll") for (int i = 0; i < 4; ++i) { \
        X[q][i][0] += G1[i][0] * bflo(D[q][i][0]); X[q][i][1] += G1[i][1] * bfhi(D[q][i][0]); \
        X[q][i][2] += G1[i][2] * bflo(D[q][i][1]); X[q][i][3] += G1[i][3] * bfhi(D[q][i][1]); \
        ss += X[q][i][0] * X[q][i][0] + X[q][i][1] * X[q][i][1] + X[q][i][2] * X[q][i][2] + X[q][i][3] * X[q][i][3]; } \
      ss = wsum(ss); \
      const float r = rsqrtf(ss * (1.f / 1024.f) + EPS); \
      _Pragma("unroll") for (int i = 0; i < 4; ++i) { \
        f32x4 o = {X[q][i][0] * r * GW[i][0], X[q][i][1] * r * GW[i][1], X[q][i][2] * r * GW[i][2], X[q][i][3] * r * GW[i][3]}; \
        *reinterpret_cast<f32x4*>(xo + (size_t)idx * 1024 + (i * 64 + lane) * 4) = o; } } } } while (0)
  int ib = i0;
  LOADSET(XA, DA, ib);
  while (ib < SEQ) {
    LOADSET(XB, DB, ib + 2 * istep);
    PROCSET(XA, DA, ib);
    ib += 2 * istep; if (ib >= SEQ) break;
    LOADSET(XA, DA, ib + 2 * istep);
    PROCSET(XB, DB, ib);
    ib += 2 * istep;
  }
#undef LOADSET
#undef PROCSET
}

DEVI bool is_t0(int wv) { return wv == 0 && __builtin_amdgcn_mbcnt_hi(~0u, __builtin_amdgcn_mbcnt_lo(~0u, 0u)) == 0u; }
#define XB_TMO      128
#define XB_XCNT(j)  (256  + 64 * (j))
#define XB_XSUB(j)  (1280 + 64 * (j))
#define XB_XGEN(j)  (2304 + 64 * (j))
#define XB_TOP      3328
#define XB_TOPGEN   3392
#define XB_SPIN_CAP (1u << 18)
#define LAS __attribute__((address_space(3)))
DEVI unsigned xb_ld(unsigned* p)              { return __hip_atomic_load(p, __ATOMIC_RELAXED, __HIP_MEMORY_SCOPE_AGENT); }
DEVI unsigned xb_add(unsigned* p, unsigned v) { return __hip_atomic_fetch_add(p, v, __ATOMIC_RELAXED, __HIP_MEMORY_SCOPE_AGENT); }
DEVI unsigned xb_xcc_id() { return (unsigned)__builtin_amdgcn_s_getreg((3 << 11) | 20) & 0xFu; }
#define XB_SPIN(cond, bar) do { unsigned _sp = 0; while (cond) { __builtin_amdgcn_s_sleep(1); \
    if ((++_sp & 255u) == 0u) { if (xb_ld(&(bar)[XB_TMO])) break; if (_sp > XB_SPIN_CAP) { atomicAdd(&(bar)[XB_TMO], 1u); break; } } } } while (0)
DEVI void xcd_barrier_complete(unsigned* bar, unsigned x, unsigned& nloc, unsigned& nx) {
  const unsigned G = gridDim.x * gridDim.y * gridDim.z;
  unsigned sum, cnt, mine, sp = 0u;
  for (;;) {
    sum = 0u; cnt = 0u; mine = 0u;
#pragma unroll
    for (unsigned j = 0; j < 16; ++j) { const unsigned c = xb_ld(&bar[XB_XCNT(j)]); sum += c; cnt += (c > 0u) ? 1u : 0u; mine = (j == x) ? c : mine; }
    if (sum == G) break;
    __builtin_amdgcn_s_sleep(1);
    if ((++sp & 255u) == 0u) { if (xb_ld(&bar[XB_TMO])) break; if (sp > XB_SPIN_CAP) { atomicAdd(&bar[XB_TMO], 1u); break; } }
  }
  nloc = mine > 0u ? mine : 1u; nx = cnt > 0u ? cnt : 1u;
}
DEVI void xcd_barrier(char* ws, char* lds, int wv) {
  asm volatile("s_waitcnt vmcnt(0)" ::: "memory");
  __syncthreads();
  if (is_t0(wv)) {
    unsigned* bar = reinterpret_cast<unsigned*>(ws + O_XBAR);
    volatile LAS unsigned* st = (volatile LAS unsigned*)(unsigned)((unsigned)(uintptr_t)lds + LDS_BYTES);
    const unsigned x = xb_xcc_id();
    __builtin_amdgcn_s_waitcnt(0);
    unsigned nloc = st[0], nx = st[1];
    if (nloc == 0u) { xcd_barrier_complete(bar, x, nloc, nx); st[0] = nloc; st[1] = nx; }
    const unsigned old = xb_add(&bar[XB_XSUB(x)], 1u);
    const unsigned gen = old / nloc;
    if (old + 1u == (gen + 1u) * nloc) {
      __builtin_amdgcn_fence(__ATOMIC_RELEASE, "agent");
      asm volatile("s_waitcnt vmcnt(0)" ::: "memory");
      const unsigned og = xb_add(&bar[XB_TOP], 1u);
      const unsigned tg = og / nx;
      if (og + 1u == (tg + 1u) * nx) xb_add(&bar[XB_TOPGEN], 1u);
      else XB_SPIN(xb_ld(&bar[XB_TOPGEN]) == tg, bar);
      __builtin_amdgcn_fence(__ATOMIC_ACQUIRE, "agent");
      xb_add(&bar[XB_XGEN(x)], 1u);
      asm volatile("s_waitcnt vmcnt(0)" ::: "memory");
    } else {
      XB_SPIN(xb_ld(&bar[XB_XGEN(x)]) == gen, bar);
      __builtin_amdgcn_fence(__ATOMIC_ACQUIRE, "agent");
      asm volatile("s_waitcnt vmcnt(0)" ::: "memory");
    }
  }
  __syncthreads();
}

DEVI void gsync(unsigned* ctr, unsigned gen, int wv) {
  asm volatile("s_waitcnt vmcnt(0)" ::: "memory");
  __syncthreads();
  if (is_t0(wv)) {
    __builtin_amdgcn_fence(__ATOMIC_RELEASE, "agent");
    asm volatile("s_waitcnt vmcnt(0)" ::: "memory");
    __hip_atomic_fetch_add(ctr, 1u, __ATOMIC_RELAXED, __HIP_MEMORY_SCOPE_AGENT);
    const unsigned target = gen * gridDim.x;
    while (__hip_atomic_load(ctr, __ATOMIC_RELAXED, __HIP_MEMORY_SCOPE_AGENT) < target) __builtin_amdgcn_s_sleep(1);
    __builtin_amdgcn_fence(__ATOMIC_ACQUIRE, "agent");
    asm volatile("s_waitcnt vmcnt(0)" ::: "memory");
  }
  __syncthreads();
}

#ifndef PH_MASK
#define PH_MASK 0xff
#endif
#ifndef REP_MASK
#define REP_MASK 0
#endif
__global__ void __launch_bounds__(NTHR) fwd_megakernel(Params P) {
  extern __shared__ __attribute__((aligned(16))) char lds[];
  cg::grid_group grid = cg::this_grid();
  const int wv = __builtin_amdgcn_readfirstlane((int)(threadIdx.x >> 6));
  {
    volatile LAS unsigned* xst = (volatile LAS unsigned*)(unsigned)((unsigned)(uintptr_t)lds + LDS_BYTES);
    if (threadIdx.x == 0) { xst[0] = 0u; xst[1] = 0u; (void)xb_add(reinterpret_cast<unsigned*>(P.ws + O_XBAR) + XB_XCNT(xb_xcc_id()), 1u); }
    __syncthreads();
  }
  if constexpr (PH_MASK & 1) phase_prep(wv, P, lds);
  grid.sync();
#pragma nounroll
  for (int layer = 0; layer < 2; ++layer) {
    const bool last = layer == 1;
    unsigned* bar = reinterpret_cast<unsigned*>(ows(P.ws + O_BAR));
    const unsigned g0 = layer * 6;
    if constexpr (PH_MASK & 2) phase_hnorm(wv, P, layer);
    if constexpr (PH_MASK & 1) { if (layer == 0) phase_wprep(wv, P); }
    xcd_barrier(P.ws, lds, wv);
    if constexpr (PH_MASK & 4) phase_gemm_in(wv, P, layer, last, lds);
    xcd_barrier(P.ws, lds, wv);
    if constexpr (PH_MASK & 8) phase_rows(wv, P, layer, last, lds);
    if constexpr (REP_MASK & 8) { __syncthreads(); phase_rows(wv, P, layer, last, lds); }
    xcd_barrier(P.ws, lds, wv);
    if constexpr (PH_MASK & 16) phase_gemm_mid(wv, P, layer, last, lds);
    if constexpr (REP_MASK & 16) { __syncthreads(); phase_gemm_mid(wv, P, layer, last, lds); }
    xcd_barrier(P.ws, lds, wv);
    unsigned badmask = 0u;
    if constexpr (PH_MASK & 32) badmask = phase_attn<true>(wv, P, last, lds, 0u);
    if (badmask && is_t0(wv)) __hip_atomic_fetch_add(bar + 16 + layer, 1u, __ATOMIC_RELAXED, __HIP_MEMORY_SCOPE_AGENT);
    xcd_barrier(P.ws, lds, wv);
    if (__hip_atomic_load(bar + 16 + layer, __ATOMIC_RELAXED, __HIP_MEMORY_SCOPE_AGENT) != 0u) {
      if constexpr (PH_MASK & 32) phase_attn<false>(wv, P, last, lds, badmask);
      xcd_barrier(P.ws, lds, wv);
    }
    if constexpr (PH_MASK & 64) phase_gemm_out(wv, P, layer, last, lds);
    if constexpr (REP_MASK & 64) { if (!last) { __syncthreads(); phase_gemm_out(wv, P, layer, last, lds); } }
    xcd_barrier(P.ws, lds, wv);
  }
  if constexpr (PH_MASK & 128) phase_final(wv, P);
}

extern "C" void kernel_launch(void* const* d_in, const int* in_sizes, int n_in, void* d_out, int out_size, void* d_ws, size_t ws_size, hipStream_t stream) {
  static int grid_blocks = 0;
  if (!grid_blocks) {
    int dev = 0, cus = 0, per_cu = 0;
    hipGetDevice(&dev);
    hipDeviceGetAttribute(&cus, hipDeviceAttributeMultiprocessorCount, dev);
    hipFuncSetAttribute((const void*)fwd_megakernel, hipFuncAttributeMaxDynamicSharedMemorySize, LDS_BYTES + 16);
    hipOccupancyMaxActiveBlocksPerMultiprocessor(&per_cu, fwd_megakernel, NTHR, LDS_BYTES + 16);
    if (per_cu < 1) { fprintf(stderr, "kernel_launch: occupancy query returned %d\n", per_cu); per_cu = 1; }
    grid_blocks = cus;
    if (ws_size < O_END) fprintf(stderr, "kernel_launch: workspace too small: %zu < %zu\n", ws_size, (size_t)O_END);
  }
  Params p{};
  const float** f = reinterpret_cast<const float**>(&p);
  for (int i = 0; i < 22; ++i) f[i] = static_cast<const float*>(d_in[i]);
  p.out = static_cast<float*>(d_out);
  p.ws = static_cast<char*>(d_ws);
  hipMemsetAsync(p.ws + O_BAR, 0, 256 + 3456 * 4, stream);
  void* args[] = {&p};
  hipError_t e = hipLaunchCooperativeKernel((const void*)fwd_megakernel, dim3(grid_blocks), dim3(NTHR), args, LDS_BYTES + 16, stream);
  if (e != hipSuccess) fprintf(stderr, "cooperative launch failed: %s (grid %d)\n", hipGetErrorString(e), grid_blocks);
}
```
